# Optimizing an MI355X kernel written in HIP

```python
import jax, jax.numpy as jnp
from jax import lax
import numpy as np

D_MODEL = 1024
BATCH = 32
SEQ = 2048
DEPTH = 1

HG_HEADS = 8
HG_DK = 128
HG_DV = D_MODEL // HG_HEADS
HG_KW = HG_HEADS * HG_DK
HG_VW = HG_HEADS * HG_DV
HG_CHUNK = 64

NSA_HEADS = 16
NSA_KV_HEADS = 4
NSA_GROUP = NSA_HEADS // NSA_KV_HEADS
NSA_DIM = 64
NSA_QW = NSA_HEADS * NSA_DIM
NSA_KVW = NSA_KV_HEADS * NSA_DIM
CMP_LEN = 32
CMP_STRIDE = 16
CMP_HIDDEN = 256
SEL_BLOCK = 64
SEL_TOPN = 8
SEL_FORCE = 1000.0
WINDOW = 512
NSA_Q_BLOCK = 32
ROPE_THETA = 10000.0

D_FF = ((8 * D_MODEL + 3 * 256 - 1) // (3 * 256)) * 256

DN_ALPHA = (2.0 * DEPTH) ** 0.25
DN_BETA = (8.0 * DEPTH) ** -0.25
LN_EPS = 1e-5
RMS_EPS = 1e-6

IN_SIZES = (HG_KW, HG_KW, HG_VW, HG_VW,
            NSA_QW, NSA_KVW, NSA_KVW, NSA_KVW, NSA_KVW, NSA_KVW, NSA_KVW,
            3 * NSA_HEADS, D_MODEL, D_MODEL)
IN_SPLITS = tuple(int(v) for v in np.cumsum(IN_SIZES)[:-1])
N_IN = int(sum(IN_SIZES))

kernel_name = 'hybrid_hgrn2_nsa_deepnorm_block'


def layer_norm(x, g, b):
    x = x.astype(jnp.float32)
    mu = jnp.mean(x, -1, keepdims=True)
    var = jnp.mean(jnp.square(x - mu), -1, keepdims=True)
    return (x - mu) * lax.rsqrt(var + LN_EPS) * g.astype(jnp.float32) + b.astype(jnp.float32)


def rope(x, positions):
    half = x.shape[-1] // 2
    inv_freq = ROPE_THETA ** (-jnp.arange(half, dtype=jnp.float32) / half)
    ang = positions.astype(jnp.float32)[..., None] * inv_freq
    cos = jnp.cos(ang)[:, :, None, :]
    sin = jnp.sin(ang)[:, :, None, :]
    x = x.astype(jnp.float32)
    x1, x2 = x[..., :half], x[..., half:]
    return jnp.concatenate([x1 * cos - x2 * sin, x2 * cos + x1 * sin], -1)


def masked_softmax(s, mask):
    s = jnp.where(mask, s, -1e30)
    m = jnp.max(s, -1, keepdims=True)
    e = jnp.where(mask, jnp.exp(s - m), 0.0)
    return e / jnp.maximum(jnp.sum(e, -1, keepdims=True), 1e-30)


def overlap_matrix(n_cmp, n_blk):
    cs = np.arange(n_cmp)[:, None] * CMP_STRIDE
    bs = np.arange(n_blk)[None, :] * SEL_BLOCK
    ov = np.minimum(cs + CMP_LEN, bs + SEL_BLOCK) - np.maximum(cs, bs)
    return (np.clip(ov, 0, None) / CMP_LEN).astype(np.float32)


def hgrn2_mix(q, f_logit, i, g, lb, norm_g):
    f32 = jnp.float32
    B, S, _ = q.shape
    H, C = HG_HEADS, HG_CHUNK
    nc = S // C

    def heads(t, d):
        return t.astype(f32).reshape(B, nc, C, H, d).transpose(0, 3, 1, 2, 4)

    f = lb + (1.0 - lb) * jax.nn.sigmoid(f_logit.astype(f32))
    q_h = heads(q, HG_DK)
    k_h = heads(1.0 - f, HG_DK)
    v_h = heads(i, HG_DV)
    b = jnp.cumsum(heads(jnp.log(f), HG_DK), axis=3)
    b_last = b[:, :, :, -1:, :]
    q_dec = q_h * jnp.exp(b)
    k_inv = k_h * jnp.exp(-b)
    k_end = k_h * jnp.exp(b_last - b)
    causal = jnp.tril(jnp.ones((C, C), dtype=bool))
    attn = jnp.where(causal, jnp.einsum('bhntk,bhnsk->bhnts', q_dec, k_inv), 0.0)
    o_intra = jnp.einsum('bhnts,bhnsv->bhntv', attn, v_h)

    def step(state, xs):
        qd, ke, v, decay = xs
        o = jnp.einsum('bhtk,bhkv->bhtv', qd, state)
        state = decay[..., None] * state + jnp.einsum('bhsk,bhsv->bhkv', ke, v)
        return state, o

    xs = (jnp.moveaxis(q_dec, 2, 0), jnp.moveaxis(k_end, 2, 0), jnp.moveaxis(v_h, 2, 0),
          jnp.moveaxis(jnp.exp(b_last[:, :, :, 0, :]), 2, 0))
    state0 = jnp.zeros((B, H, HG_DK, HG_DV), f32)
    _, o_inter = lax.scan(step, state0, xs)
    o = o_intra + jnp.moveaxis(o_inter, 0, 2)
    o = o.transpose(0, 2, 3, 1, 4).reshape(B, S, H, HG_DV)
    o = o * lax.rsqrt(jnp.mean(jnp.square(o), -1, keepdims=True) + RMS_EPS) * norm_g.astype(f32)
    return o.reshape(B, S, HG_VW) * jax.nn.silu(g.astype(f32))


def compress(t, pos_emb, w1, b1, w2, b2):
    B, S, H, d = t.shape
    n_cmp = (S - CMP_LEN) // CMP_STRIDE + 1
    idx = np.arange(n_cmp)[:, None] * CMP_STRIDE + np.arange(CMP_LEN)[None, :]
    blk = t[:, idx] + pos_emb[None, None, :, None, :]
    blk = blk.transpose(0, 1, 3, 2, 4).reshape(B, n_cmp, H, CMP_LEN * d)
    hdn = jax.nn.silu(blk @ w1 + b1)
    return hdn @ w2 + b2


def nsa_mix(q, k_cmp, v_cmp, k_sel, v_sel, k_win, v_win, gates):
    f32 = jnp.float32
    B, S = q.shape[:2]
    KV, G, D, QB = NSA_KV_HEADS, NSA_GROUP, NSA_DIM, NSA_Q_BLOCK
    n_blk = S // SEL_BLOCK
    top_n = min(SEL_TOPN, n_blk)
    n_cmp = k_cmp.shape[1]
    cmp_end = jnp.asarray(np.arange(n_cmp) * CMP_STRIDE + CMP_LEN - 1)
    overlap = jnp.asarray(overlap_matrix(n_cmp, n_blk))
    scale = D ** -0.5
    ks_blk = k_sel.reshape(B, n_blk, SEL_BLOCK, KV, D).transpose(0, 3, 1, 2, 4)
    vs_blk = v_sel.reshape(B, n_blk, SEL_BLOCK, KV, D).transpose(0, 3, 1, 2, 4)
    kw_pad = jnp.pad(k_win, ((0, 0), (WINDOW, 0), (0, 0), (0, 0)))
    vw_pad = jnp.pad(v_win, ((0, 0), (WINDOW, 0), (0, 0), (0, 0)))
    gates = jax.nn.sigmoid(gates.astype(f32)).reshape(B, S, 3, KV, G)
    b_idx = jnp.arange(B)[:, None, None, None]
    h_idx = jnp.arange(KV)[None, :, None, None]
    blk_ids = jnp.arange(n_blk)
    sub_pos = jnp.arange(SEL_BLOCK)

    def one_block(i):
        q0 = i * QB
        t = q0 + jnp.arange(QB)
        qb = lax.dynamic_slice_in_dim(q, q0, QB, 1).reshape(B, QB, KV, G, D)
        s_c = jnp.einsum('bqhgd,bnhd->bhgqn', qb, k_cmp) * scale
        p_c = masked_softmax(s_c, cmp_end[None, :] <= t[:, None])
        o_c = jnp.einsum('bhgqn,bnhd->bqhgd', p_c, v_cmp)
        imp = jnp.einsum('bhgqn,nk->bhqk', p_c, overlap)
        cur = t // SEL_BLOCK
        blk_ok = blk_ids[None, :] <= cur[:, None]
        forced = ((blk_ids[None, :] == 0) | (blk_ids[None, :] == cur[:, None])
                  | (blk_ids[None, :] == cur[:, None] - 1))
        score = jnp.where(blk_ok, imp + SEL_FORCE * forced, -1.0)
        _, sel = lax.top_k(score, top_n)
        sel_ok = sel <= cur[None, None, :, None]
        k_g = ks_blk[b_idx, h_idx, sel].reshape(B, KV, QB, top_n * SEL_BLOCK, D)
        v_g = vs_blk[b_idx, h_idx, sel].reshape(B, KV, QB, top_n * SEL_BLOCK, D)
        key_pos = sel[..., None] * SEL_BLOCK + sub_pos
        mask_s = (sel_ok[..., None] & (key_pos <= t[None, None, :, None, None])
                  ).reshape(B, KV, QB, top_n * SEL_BLOCK)
        s_s = jnp.einsum('bqhgd,bhqmd->bhgqm', qb, k_g) * scale
        p_s = masked_softmax(s_s, mask_s[:, :, None])
        o_s = jnp.einsum('bhgqm,bhqmd->bqhgd', p_s, v_g)
        k_wb = lax.dynamic_slice_in_dim(kw_pad, q0, WINDOW + QB, 1)
        v_wb = lax.dynamic_slice_in_dim(vw_pad, q0, WINDOW + QB, 1)
        w_pos = q0 - WINDOW + jnp.arange(WINDOW + QB)
        mask_w = ((w_pos[None, :] >= 0) & (w_pos[None, :] <= t[:, None])
                  & (w_pos[None, :] > t[:, None] - WINDOW))
        s_w = jnp.einsum('bqhgd,bkhd->bhgqk', qb, k_wb) * scale
        p_w = masked_softmax(s_w, mask_w)
        o_w = jnp.einsum('bhgqk,bkhd->bqhgd', p_w, v_wb)
        g = lax.dynamic_slice_in_dim(gates, q0, QB, 1)
        o = (g[:, :, 0, :, :, None] * o_c + g[:, :, 1, :, :, None] * o_s
             + g[:, :, 2, :, :, None] * o_w)
        return o.reshape(B, QB, NSA_QW)

    out = lax.map(one_block, jnp.arange(S // QB))
    return out.transpose(1, 0, 2, 3).reshape(B, S, NSA_QW)


def setup_inputs(seed: int = 0) -> dict:
    key = jax.random.key(seed)
    ks = jax.random.split(key, 32)
    n = lambda k, shape: jax.random.normal(k, shape, jnp.float32)
    L = DEPTH
    cin = CMP_LEN * NSA_DIM
    return {
        'x': n(ks[0], (BATCH, SEQ, D_MODEL)),
        'positions': jnp.broadcast_to(jnp.arange(SEQ, dtype=jnp.int32), (BATCH, SEQ)),
        'w_in': n(ks[1], (L, D_MODEL, N_IN)) * D_MODEL ** -0.5,
        'hg_lb_logits': n(ks[2], (DEPTH + 1, HG_KW)) * 0.5,
        'hg_norm_g': 1.0 + 0.02 * n(ks[3], (L, HG_DV)),
        'cmp_k_pos': 0.02 * n(ks[4], (L, CMP_LEN, NSA_DIM)),
        'cmp_k_w1': n(ks[5], (L, cin, CMP_HIDDEN)) * cin ** -0.5,
        'cmp_k_b1': 0.01 * n(ks[6], (L, CMP_HIDDEN)),
        'cmp_k_w2': n(ks[7], (L, CMP_HIDDEN, NSA_DIM)) * CMP_HIDDEN ** -0.5,
        'cmp_k_b2': 0.01 * n(ks[8], (L, NSA_DIM)),
        'cmp_v_pos': 0.02 * n(ks[9], (L, CMP_LEN, NSA_DIM)),
        'cmp_v_w1': n(ks[10], (L, cin, CMP_HIDDEN)) * cin ** -0.5,
        'cmp_v_b1': 0.01 * n(ks[11], (L, CMP_HIDDEN)),
        'cmp_v_w2': n(ks[12], (L, CMP_HIDDEN, NSA_DIM)) * CMP_HIDDEN ** -0.5,
        'cmp_v_b2': 0.01 * n(ks[13], (L, NSA_DIM)),
        'w_up_hg': n(ks[14], (L, HG_VW, D_MODEL)) * HG_VW ** -0.5,
        'w_up_nsa': n(ks[15], (L, NSA_QW, D_MODEL)) * NSA_QW ** -0.5,
        'w_o': n(ks[16], (L, D_MODEL, D_MODEL)) * (D_MODEL ** -0.5 * DN_BETA),
        'ln1_g': 1.0 + 0.02 * n(ks[17], (L, D_MODEL)),
        'ln1_b': 0.02 * n(ks[18], (L, D_MODEL)),
        'w_ffn_gate': n(ks[19], (L, D_MODEL, D_FF)) * D_MODEL ** -0.5,
        'w_ffn_up': n(ks[20], (L, D_MODEL, D_FF)) * D_MODEL ** -0.5,
        'w_ffn_down': n(ks[21], (L, D_FF, D_MODEL)) * (D_FF ** -0.5 * DN_BETA),
        'ln2_g': 1.0 + 0.02 * n(ks[22], (L, D_MODEL)),
        'ln2_b': 0.02 * n(ks[23], (L, D_MODEL)),
    }


def reference(x, positions, w_in, hg_lb_logits, hg_norm_g,
              cmp_k_pos, cmp_k_w1, cmp_k_b1, cmp_k_w2, cmp_k_b2,
              cmp_v_pos, cmp_v_w1, cmp_v_b1, cmp_v_w2, cmp_v_b2,
              w_up_hg, w_up_nsa, w_o, ln1_g, ln1_b,
              w_ffn_gate, w_ffn_up, w_ffn_down, ln2_g, ln2_b):
    f32 = jnp.float32
    B, S, _ = x.shape
    lb_table = jnp.cumsum(jax.nn.softmax(hg_lb_logits.astype(f32), axis=0), axis=0)

    def kv_heads(t):
        return t.astype(f32).reshape(B, S, NSA_KV_HEADS, NSA_DIM)

    h = x
    for l in range(DEPTH):
        proj = jnp.einsum('bsd,dc->bsc', h, w_in[l])
        (hg_q, hg_f, hg_i, hg_g, nsa_q, k_c, v_c, k_s, v_s, k_w, v_w,
         nsa_gate, gate_a, gate_b) = jnp.split(proj, IN_SPLITS, axis=-1)

        a = hgrn2_mix(hg_q, hg_f, hg_i, hg_g, lb_table[l], hg_norm_g[l])

        q = rope(nsa_q.reshape(B, S, NSA_HEADS, NSA_DIM), positions)
        k_cmp = compress(rope(kv_heads(k_c), positions), cmp_k_pos[l], cmp_k_w1[l],
                         cmp_k_b1[l], cmp_k_w2[l], cmp_k_b2[l])
        v_cmp = compress(kv_heads(v_c), cmp_v_pos[l], cmp_v_w1[l],
                         cmp_v_b1[l], cmp_v_w2[l], cmp_v_b2[l])
        b_out = nsa_mix(q, k_cmp, v_cmp,
                        rope(kv_heads(k_s), positions), kv_heads(v_s),
                        rope(kv_heads(k_w), positions), kv_heads(v_w), nsa_gate)

        a_d = a @ w_up_hg[l]
        b_d = b_out @ w_up_nsa[l]
        merged = (jax.nn.sigmoid(gate_a.astype(f32)) * a_d
                  + jax.nn.sigmoid(gate_b.astype(f32)) * b_d)
        mix = merged @ w_o[l]
        h = layer_norm(DN_ALPHA * h + mix, ln1_g[l], ln1_b[l]).astype(x.dtype)

        ffn = (jax.nn.silu(h @ w_ffn_gate[l]) * (h @ w_ffn_up[l])) @ w_ffn_down[l]
        h = layer_norm(DN_ALPHA * h + ffn, ln2_g[l], ln2_b[l]).astype(x.dtype)
    return h
```

```cpp
#include <hip/hip_runtime.h>
#include <cstdio>
#include <cstdint>
#ifndef DBG_EXP
#define DBG_EXP 0
#endif
#ifndef DBG_CHK
#define DBG_CHK 0
#endif
namespace pg8 {
#define PG8_LAS __attribute__((address_space(3)))
typedef unsigned short bf16_t;
typedef short bf16x8 __attribute__((ext_vector_type(8)));
typedef float f32x4 __attribute__((ext_vector_type(4)));
typedef unsigned u32x4 __attribute__((ext_vector_type(4)));
constexpr int BM = 256, BK = 64, HALF = 128, HTB = HALF * BK * 2  , STAGE_BYTES = 8 * HTB, NXCD = 8, WGM = 8;

__host__ __device__ __forceinline__ int lds_byte(int r, int c) { const int st = (r >> 4) * 2 + (c >> 5), rr = r & 15, cc = c & 31, ob = rr * 64 + cc * 2; return st * 1024 + (ob ^ (((ob >> 9) & 1) << 5)); }
__host__ __device__ __forceinline__ void stage_rc(int b, int& R, int& C) { const int st = b / 1024, sb = b % 1024, swz = sb ^ (((sb >> 9) & 1) << 5); R = (st >> 1) * 16 + swz / 64; C = (st & 1) * 32 + (swz % 64) / 2; }
__host__ __device__ __forceinline__ int perm32(int rho) { const int n = rho >> 4, i = rho & 15; return 8 * (i >> 2) + 4 * n + (i & 3); }

struct Unit { int pm, pn; };
struct Gemm { const bf16_t* A; const bf16_t* Bt; int M, N, K, lda; };

struct StaticOrder {
    int nM, nN, nwg, G, c;
    __host__ __device__ void init(int M, int N, int G_, int c_) { nM = M / BM; nN = N / BM; nwg = nM * nN; G = G_; c = c_; }
    __host__ __device__ bool next(int i, Unit& u) const {
        const long L = (long)i * G + c; if (L >= nwg) return false;
        int wgid = (int)L; { const int q = nwg / NXCD, r = nwg % NXCD, xcd = wgid % NXCD, off = wgid / NXCD; wgid = (xcd < r ? xcd * (q + 1) : r * (q + 1) + (xcd - r) * q) + off; }
        const int nig = WGM * nN, gid = wgid / nig, fm = gid * WGM, gsz = (nM - fm) < WGM ? (nM - fm) : WGM;
        u.pm = fm + ((wgid % nig) % gsz); u.pn = (wgid % nig) / gsz; return true;
    }
    __device__ __forceinline__ void a_ready(const Unit&) const {}
    __device__ __forceinline__ void done(const Unit&) const {}
};

__device__ __forceinline__ unsigned cvt_pk_bf16(float lo, float hi) { unsigned r; asm volatile("v_cvt_pk_bf16_f32 %0, %1, %2" : "=v"(r) : "v"(lo), "v"(hi)); return r; }
template <class Epi, class Sched, bool ALIGN_EPI = false, bool SP2 = false>
__device__ __forceinline__ void gemm_phase(PG8_LAS unsigned char* lds, const Gemm g, const Sched& S, const Epi& E) {
    int tid_ = threadIdx.x; asm volatile("" : "+v"(tid_)); const int tid = tid_, wid = __builtin_amdgcn_readfirstlane(tid >> 6), lane = tid & 63, wr = wid >> 2, wc = wid & 3, fr = lane & 15, fq = lane >> 4;
    const int K = g.K, nt = K / BK;
    unsigned voffA[2], voffB[2];
#pragma unroll
    for (int i = 0; i < 2; ++i) { int R, C; stage_rc(tid * 16 + i * 8192, R, C); const int Rb = Epi::PERM ? ((R & ~31) + perm32(R & 31)) : R;
        voffA[i] = (unsigned)(R * g.lda + C) * 2u; voffB[i] = (unsigned)(Rb * K + C) * 2u; }
    const size_t kstep = (size_t)(BK * 2);
    const size_t hstepA = (size_t)HALF * g.lda * 2, hstepB = (size_t)HALF * K * 2;
    const size_t tstepA = 2 * hstepA, tstepB = 2 * hstepB;
    const unsigned ldsw = (unsigned)wid * 1024u;
    const int aoff = lds_byte(wr * 64 + fr, fq * 8), boff = lds_byte(wc * 32 + fr, fq * 8);
#define PG8_SA(b, h) (((b) * 2 + (h)) * HTB)
#define PG8_SB(b, h) ((4 + (b) * 2 + (h)) * HTB)
#define PG8_STAGE(bufoff, gbase, voff) do { _Pragma("unroll") for (int _i = 0; _i < 2; ++_i) \
        __builtin_amdgcn_global_load_lds((const unsigned*)((const char*)(gbase) + (voff)[_i]), (PG8_LAS unsigned*)(lds + (bufoff) + ldsw + _i * 8192), 16, 0, 0); } while (0)
#define PG8_LDA(dst, b, h) do { _Pragma("unroll") for (int m = 0; m < 4; ++m) _Pragma("unroll") for (int k = 0; k < 2; ++k) dst[m][k] = *(const PG8_LAS bf16x8*)(lds + PG8_SA(b, h) + aoff + m * 2048 + k * 1024); } while (0)
#define PG8_LDB(dst, b, h) do { _Pragma("unroll") for (int n = 0; n < 2; ++n) _Pragma("unroll") for (int k = 0; k < 2; ++k) dst[n][k] = *(const PG8_LAS bf16x8*)(lds + PG8_SB(b, h) + boff + n * 2048 + k * 1024); } while (0)
#define PG8_MMA(ai, bj, At, Bt) do { __builtin_amdgcn_s_setprio(1); _Pragma("unroll") for (int m = 0; m < 4; ++m) _Pragma("unroll") for (int n = 0; n < 2; ++n) _Pragma("unroll") for (int k = 0; k < 2; ++k) \
        acc[ai][bj][m][n] = __builtin_amdgcn_mfma_f32_16x16x32_bf16(Bt[n][k], At[m][k], acc[ai][bj][m][n], 0, 0, 0); __builtin_amdgcn_s_setprio(0); } while (0)
#define PG8_WAIT_V(n) asm volatile("s_waitcnt vmcnt(" #n ")" ::: "memory")
#define PG8_WAIT_L(n) asm volatile("s_waitcnt lgkmcnt(" #n ")" ::: "memory")
#define PG8_BAR __builtin_amdgcn_s_barrier()
#define PG8_SCHED __builtin_amdgcn_sched_barrier(0)
    Unit cur, nxt; int ui = 0;
    if (!S.next(0, cur)) return;
    f32x4 acc[2][2][4][2];
#pragma unroll
    for (int a = 0; a < 2; ++a)
#pragma unroll
        for (int b = 0; b < 2; ++b)
#pragma unroll
            for (int m = 0; m < 4; ++m)
#pragma unroll
                for (int n = 0; n < 2; ++n) acc[a][b][m][n] = (f32x4){0.f, 0.f, 0.f, 0.f};
    bf16x8 At[4][2], B0[2][2], B1[2][2];
    const char* cA = (const char*)g.A + (size_t)cur.pm * tstepA; const char* cB = (const char*)g.Bt + (size_t)cur.pn * tstepB;
    S.a_ready(cur);
    if constexpr (SP2) {
        PG8_STAGE(PG8_SB(0, 0), cB, voffB); PG8_STAGE(PG8_SB(0, 1), cB + hstepB, voffB); PG8_STAGE(PG8_SA(0, 0), cA, voffA); PG8_STAGE(PG8_SA(0, 1), cA + hstepA, voffA);
        if (wr == 1) PG8_BAR;
        PG8_WAIT_V(2); PG8_BAR;
        PG8_STAGE(PG8_SB(1, 0), cB + kstep, voffB); PG8_STAGE(PG8_SA(1, 0), cA + kstep, voffA); PG8_STAGE(PG8_SB(1, 1), cB + hstepB + kstep, voffB);
        PG8_WAIT_V(6); PG8_BAR;
    } else {
        PG8_STAGE(PG8_SB(0, 0), cB, voffB); PG8_STAGE(PG8_SA(0, 0), cA, voffA); PG8_STAGE(PG8_SB(0, 1), cB + hstepB, voffB); PG8_STAGE(PG8_SA(0, 1), cA + hstepA, voffA);
        if (wr == 1) PG8_BAR;
        PG8_WAIT_V(4); PG8_BAR;
        PG8_STAGE(PG8_SB(1, 0), cB + kstep, voffB); PG8_STAGE(PG8_SA(1, 0), cA + kstep, voffA); PG8_STAGE(PG8_SB(1, 1), cB + hstepB + kstep, voffB);
        PG8_WAIT_V(6); PG8_BAR;
    }
    for (;;) {
        const bool has_next = S.next(ui + 1, nxt);
        const char* nA = has_next ? (const char*)g.A + (size_t)nxt.pm * tstepA : cA; const char* nB = has_next ? (const char*)g.Bt + (size_t)nxt.pn * tstepB : cB;
        for (int t = 0; t < nt; t += 2) {
            const bool last = (t == nt - 2);
            const char* a1 = cA + (size_t)(t + 1) * kstep;
            const char* a2 = last ? nA : cA + (size_t)(t + 2) * kstep; const char* b2 = last ? nB : cB + (size_t)(t + 2) * kstep;
            const char* a3 = a2 + kstep; const char* b3 = b2 + kstep;
            if (last && has_next) S.a_ready(nxt);
            if constexpr (SP2) {
            PG8_LDB(B0, 0, 0); PG8_LDB(B1, 0, 1); PG8_SCHED; PG8_LDA(At, 0, 0); PG8_STAGE(PG8_SA(1, 1), a1 + hstepA, voffA);
            PG8_WAIT_V(8); PG8_WAIT_L(0); PG8_BAR; PG8_MMA(0, 0, At, B0); PG8_MMA(0, 1, At, B1); PG8_BAR; PG8_SCHED;
            PG8_LDA(At, 0, 1); PG8_STAGE(PG8_SB(0, 0), b2, voffB); PG8_STAGE(PG8_SB(0, 1), b2 + hstepB, voffB); PG8_STAGE(PG8_SA(0, 0), a2, voffA);
            PG8_WAIT_V(8); PG8_WAIT_L(0); PG8_BAR; PG8_MMA(1, 0, At, B0); PG8_MMA(1, 1, At, B1); PG8_BAR; PG8_SCHED;
            PG8_LDB(B0, 1, 0); PG8_LDB(B1, 1, 1); PG8_SCHED; PG8_LDA(At, 1, 0); PG8_STAGE(PG8_SA(0, 1), a2 + hstepA, voffA);
            PG8_WAIT_V(8); PG8_WAIT_L(0); PG8_BAR; PG8_MMA(0, 0, At, B0); PG8_MMA(0, 1, At, B1); PG8_BAR; PG8_SCHED;
            PG8_LDA(At, 1, 1); PG8_STAGE(PG8_SB(1, 0), b3, voffB); PG8_STAGE(PG8_SB(1, 1), b3 + hstepB, voffB); PG8_STAGE(PG8_SA(1, 0), a3, voffA);
            PG8_WAIT_V(8); PG8_WAIT_L(0); PG8_BAR; PG8_MMA(1, 0, At, B0); PG8_MMA(1, 1, At, B1); PG8_BAR; PG8_SCHED;
            } else {
            PG8_LDB(B0, 0, 0); PG8_SCHED; PG8_LDA(At, 0, 0); PG8_STAGE(PG8_SA(1, 1), a1 + hstepA, voffA);
            PG8_WAIT_L(8); PG8_BAR; PG8_WAIT_L(0); PG8_MMA(0, 0, At, B0); PG8_BAR; PG8_SCHED;
            PG8_LDB(B1, 0, 1); PG8_STAGE(PG8_SB(0, 0), b2, voffB);
            PG8_BAR; PG8_WAIT_L(0); PG8_MMA(0, 1, At, B1); PG8_BAR;
            PG8_LDA(At, 0, 1); PG8_STAGE(PG8_SA(0, 0), a2, voffA);
            PG8_BAR; PG8_WAIT_L(0); PG8_MMA(1, 0, At, B0); PG8_BAR; PG8_SCHED;
            PG8_STAGE(PG8_SB(0, 1), b2 + hstepB, voffB);
            PG8_WAIT_V(6); PG8_BAR; PG8_MMA(1, 1, At, B1); PG8_BAR;
            PG8_LDB(B0, 1, 0); PG8_SCHED; PG8_LDA(At, 1, 0); PG8_STAGE(PG8_SA(0, 1), a2 + hstepA, voffA);
            PG8_WAIT_L(8); PG8_BAR; PG8_WAIT_L(0); PG8_MMA(0, 0, At, B0); PG8_BAR; PG8_SCHED;
            PG8_LDB(B1, 1, 1); PG8_STAGE(PG8_SB(1, 0), b3, voffB);
            PG8_BAR; PG8_WAIT_L(0); PG8_MMA(0, 1, At, B1); PG8_BAR;
            PG8_LDA(At, 1, 1); PG8_STAGE(PG8_SA(1, 0), a3, voffA);
            PG8_BAR; PG8_WAIT_L(0); PG8_MMA(1, 0, At, B0); PG8_BAR; PG8_SCHED;
            PG8_STAGE(PG8_SB(1, 1), b3 + hstepB, voffB);
            PG8_WAIT_V(6); PG8_BAR; PG8_MMA(1, 1, At, B1); PG8_BAR;
            }
        }
        if constexpr (ALIGN_EPI) { if (wr == 0) PG8_BAR; }
        if constexpr (!Epi::AFTER_DRAIN) { E(acc, cur, wr, wc, fr, fq); S.done(cur); }
        if (!has_next) break;
#pragma unroll
        for (int a = 0; a < 2; ++a)
#pragma unroll
            for (int b = 0; b < 2; ++b)
#pragma unroll
                for (int m = 0; m < 4; ++m)
#pragma unroll
                    for (int n = 0; n < 2; ++n) acc[a][b][m][n] = (f32x4){0.f, 0.f, 0.f, 0.f};
        cur = nxt; cA = nA; cB = nB; ++ui;
        if constexpr (ALIGN_EPI) { if (wr == 1) PG8_BAR; }
    }
    PG8_WAIT_V(0);
    if constexpr (!ALIGN_EPI) { if (wr == 0) PG8_BAR; }
    PG8_BAR;
    if constexpr (Epi::AFTER_DRAIN) { E.fused(acc, cur, wr, wc, fr, fq, lds, wid, lane); S.done(cur); }
#undef PG8_SA
#undef PG8_SB
#undef PG8_STAGE
#undef PG8_LDA
#undef PG8_LDB
#undef PG8_MMA
#undef PG8_WAIT_V
#undef PG8_WAIT_L
#undef PG8_BAR
#undef PG8_SCHED
}
}

constexpr int S = 2048, D = 1024, BATCH = 32, BG = 16, NGRP = BATCH / BG, TG = BG * S;
constexpr int NPROJ = 8960, NSRC = 8752, DFF = 2816, NGU = 2 * DFF;
constexpr float DN_ALPHA = 1.189207115002721f, LN_EPS = 1e-5f, RMS_EPS = 1e-6f;
constexpr float SM_C = 0.125f * 1.4426950408889634f;
constexpr float NEG_BIG = -1e30f;

constexpr size_t MiB = 1u << 20;
constexpr size_t WS_CTL = 0, CTL_ZERO_BYTES = 1 * MiB;
constexpr size_t WS_WIN = 1 * MiB, WS_WA = 19 * MiB, WS_WB = 21 * MiB, WS_WO = 23 * MiB, WS_WGU = 25 * MiB, WS_WD = 36 * MiB, WS_CW1 = 42 * MiB, WS_CW2 = 44 * MiB;
constexpr size_t WS_VEC = 45 * MiB, WS_ROPE = 46 * MiB;
constexpr size_t WS_XB = 64 * MiB, WS_MERGED = 64 * MiB;
constexpr size_t WS_HQ = 128 * MiB, WS_HF = 192 * MiB, WS_HI = 256 * MiB, WS_HG = 320 * MiB, WS_NQ = 384 * MiB;
constexpr size_t WS_KC = 448 * MiB, WS_VC = 464 * MiB, WS_KS = 480 * MiB, WS_VST = 496 * MiB, WS_KW = 512 * MiB, WS_VWT = 528 * MiB, WS_ORAW = 544 * MiB;
constexpr size_t WS_PRE1 = 128 * MiB, WS_H1B = 256 * MiB, WS_HID = 320 * MiB;
constexpr size_t WS_GA = 608 * MiB, WS_GB = 672 * MiB, WS_GATES = 736 * MiB, WS_HC = 742 * MiB, WS_KCMP = 750 * MiB, WS_VCMPT = 751 * MiB;
constexpr size_t WS_AOUT = 752 * MiB, WS_BOUT = 816 * MiB, WS_END = 880 * MiB;
static_assert(WS_HF == WS_HQ + 64 * MiB && WS_HI == WS_HQ + 128 * MiB && WS_HG == WS_HQ + 192 * MiB && WS_VC == WS_KC + 16 * MiB && WS_KS == WS_KC + 32 * MiB && WS_VST == WS_KC + 48 * MiB && WS_KW == WS_KC + 64 * MiB && WS_VWT == WS_KC + 80 * MiB && WS_GB == WS_GA + 64 * MiB, "EpiProj destination arithmetic");
constexpr int VEC_LB = 0, VEC_CB1 = 1024, VEC_CB2 = 1536;
constexpr int CW_BAR = 4096;

constexpr int RING_BYTES = 131072, LDSCTL_OFF = RING_BYTES, MISC_OFF = LDSCTL_OFF + 320, LDS_BYTES = 147456;

#define GAS __attribute__((address_space(1)))
#define LAS __attribute__((address_space(3)))
typedef unsigned short bf16;
typedef unsigned v4u __attribute__((ext_vector_type(4)));
typedef unsigned v2u __attribute__((ext_vector_type(2)));
typedef float f32x4 __attribute__((ext_vector_type(4)));
typedef float f32x2 __attribute__((ext_vector_type(2)));
typedef short bf16x8 __attribute__((ext_vector_type(8)));
typedef __bf16 bf16v2 __attribute__((ext_vector_type(2)));
typedef _Float16 f16v2 __attribute__((ext_vector_type(2)));
typedef GAS unsigned gu32;
#define RLX_AGENT __ATOMIC_RELAXED, __HIP_MEMORY_SCOPE_AGENT
#define LDS_WAIT() asm volatile("s_waitcnt lgkmcnt(0)" ::: "memory")
#define VM_WAIT() asm volatile("s_waitcnt vmcnt(0)" ::: "memory")

__device__ __forceinline__ int fresh_tid() { int t = threadIdx.x; asm volatile("" : "+v"(t)); return t; }
__device__ __forceinline__ int fresh_s(int v) { asm volatile("" : "+s"(v)); return __builtin_amdgcn_readfirstlane(v); }
__device__ __forceinline__ unsigned pk2(float lo, float hi) { f32x2 v = {lo, hi}; bf16v2 r = __builtin_convertvector(v, bf16v2); return __builtin_bit_cast(unsigned, r); }
__device__ __forceinline__ unsigned pkh2(float lo, float hi) { f32x2 v = {lo, hi}; f16v2 r = __builtin_convertvector(v, f16v2); return __builtin_bit_cast(unsigned, r); }
__device__ __forceinline__ float h2f_lo(unsigned u) { return (float)__builtin_bit_cast(_Float16, (unsigned short)(u & 0xffffu)); }
__device__ __forceinline__ float h2f_hi(unsigned u) { return (float)__builtin_bit_cast(_Float16, (unsigned short)(u >> 16)); }
__device__ __forceinline__ float bflo(unsigned u) { return __uint_as_float(u << 16); }
__device__ __forceinline__ float bfhi(unsigned u) { return __uint_as_float(u & 0xffff0000u); }
__device__ __forceinline__ float fexp(float x) { return __builtin_amdgcn_exp2f(x * 1.4426950408889634f); }
__device__ __forceinline__ float frcp(float x) { return __builtin_amdgcn_rcpf(x); }
__device__ __forceinline__ float flog(float x) { return __builtin_amdgcn_logf(x) * 0.6931471805599453f; }
__device__ __forceinline__ float frsq(float x) { return __builtin_amdgcn_rsqf(x); }
__device__ __forceinline__ float sigm(float z) { return frcp(1.0f + fexp(-z)); }
__device__ __forceinline__ float siluf(float z) { return z * frcp(1.0f + fexp(-z)); }
template <int CTRL> __device__ __forceinline__ float dppf(float v) { return __builtin_bit_cast(float, __builtin_amdgcn_update_dpp(0, __builtin_bit_cast(int, v), CTRL, 0xF, 0xF, true)); }
__device__ __forceinline__ float sum4(float v) { v += dppf<0xB1>(v); v += dppf<0x4E>(v); return v; }
__device__ __forceinline__ float sum8(float v) { v = sum4(v); v += dppf<0x141>(v); return v; }
__device__ __forceinline__ float sum16(float v) { v = sum8(v); v += dppf<0x140>(v); return v; }
__device__ __forceinline__ float wave_sum(float v) {
#pragma unroll
    for (int o = 1; o < 64; o <<= 1) v += __shfl_xor(v, o);
    return v;
}

typedef __attribute__((address_space(4))) const unsigned long long* kargp_t;
__device__ __forceinline__ const void* karg(int i) {
    const unsigned long long p = (unsigned long long)__builtin_amdgcn_kernarg_segment_ptr();
    unsigned lo = (unsigned)p, hi = (unsigned)(p >> 32);
    asm volatile("" : "+s"(lo), "+s"(hi));
    lo = __builtin_amdgcn_readfirstlane(lo); hi = __builtin_amdgcn_readfirstlane(hi);
    const kargp_t ka = (kargp_t)(((unsigned long long)hi << 32) | lo);
    return (const void*)ka[i];
}
#define KIN(i) ((const float*)karg(i))
#define KOUT() ((float*)karg(25))
#define KWS() ((unsigned char*)karg(26))
#define XB_TMO      128
#define XB_XCNT(j)  (256  + 64 * (j))
#define XB_XSUB(j)  (1280 + 64 * (j))
#define XB_XGEN(j)  (2304 + 64 * (j))
#define XB_TOP      3328
#define XB_TOPGEN   3392
#define XCD_BAR_WORDS 3456
#define XB_SPIN_CAP (1u << 20)

__device__ __forceinline__ unsigned xb_ld(unsigned* p)              { return __hip_atomic_load(p, __ATOMIC_RELAXED, __HIP_MEMORY_SCOPE_AGENT); }
__device__ __forceinline__ unsigned xb_add(unsigned* p, unsigned v) { return __hip_atomic_fetch_add(p, v, __ATOMIC_RELAXED, __HIP_MEMORY_SCOPE_AGENT); }
__device__ __forceinline__ unsigned xb_xcc_id() { return (unsigned)__builtin_amdgcn_s_getreg((3 << 11) | 20) & 0xFu; }
#define XB_SPIN(cond, bar) do { unsigned _sp = 0; while (cond) { __builtin_amdgcn_s_sleep(1); \
    if ((++_sp & 255u) == 0u) { if (xb_ld(&(bar)[XB_TMO])) break; if (_sp > XB_SPIN_CAP) { atomicAdd(&(bar)[XB_TMO], 1u); break; } } } } while (0)

struct XcdBarrier { unsigned* bar; unsigned x; volatile LAS unsigned* st; };

__device__ __forceinline__ XcdBarrier xcd_barrier_post(unsigned* bar, volatile LAS unsigned* st) {
    XcdBarrier b; b.bar = bar; b.x = xb_xcc_id(); b.st = st;
    if (threadIdx.x == 0) (void)xb_add(&bar[XB_XCNT(b.x)], 1u);
    return b;
}
__device__ __forceinline__ void xcd_barrier_complete(unsigned* bar, unsigned x, unsigned& nloc, unsigned& nx) {
    const unsigned G = gridDim.x * gridDim.y * gridDim.z;
    unsigned sum, cnt, mine, sp = 0u;
    for (;;) {
        sum = 0u; cnt = 0u; mine = 0u;
#pragma unroll 1
        for (unsigned j = 0; j < 16; ++j) { const unsigned c = xb_ld(&bar[XB_XCNT(j)]); sum += c; cnt += (c > 0u) ? 1u : 0u; mine = (j == x) ? c : mine; }
        if (sum == G) break;
        __builtin_amdgcn_s_sleep(1);
        if ((++sp & 255u) == 0u) { if (xb_ld(&bar[XB_TMO])) break; if (sp > XB_SPIN_CAP) { atomicAdd(&bar[XB_TMO], 1u); break; } }
    }
    nloc = mine > 0u ? mine : 1u; nx = cnt > 0u ? cnt : 1u;
}
__device__ __forceinline__ void xcd_barrier(const XcdBarrier& b) {
    asm volatile("s_waitcnt vmcnt(0)" ::: "memory");
    __syncthreads();
    if (threadIdx.x == 0) {
        unsigned* bar = (unsigned*)(KWS() + WS_CTL) + CW_BAR;
        const unsigned bx = xb_xcc_id();
        __builtin_amdgcn_s_waitcnt(0);
        unsigned nloc = b.st[0], nx = b.st[1];
        if (nloc == 0u) { xcd_barrier_complete(bar, bx, nloc, nx); b.st[0] = nloc; b.st[1] = nx; }
        const unsigned old = xb_add(&bar[XB_XSUB(bx)], 1u);
        const unsigned gen = old / nloc;
        if (old + 1u == (gen + 1u) * nloc) {
            __builtin_amdgcn_fence(__ATOMIC_RELEASE, "agent");
            asm volatile("s_waitcnt vmcnt(0)" ::: "memory");
            const unsigned og = xb_add(&bar[XB_TOP], 1u);
            const unsigned tg = og / nx;
            if (og + 1u == (tg + 1u) * nx) xb_add(&bar[XB_TOPGEN], 1u);
            else XB_SPIN(xb_ld(&bar[XB_TOPGEN]) == tg, bar);
            __builtin_amdgcn_fence(__ATOMIC_ACQUIRE, "agent");
            xb_add(&bar[XB_XGEN(bx)], 1u);
            asm volatile("s_waitcnt vmcnt(0)" ::: "memory");
        } else {
            XB_SPIN(xb_ld(&bar[XB_XGEN(bx)]) == gen, bar);
            __builtin_amdgcn_fence(__ATOMIC_ACQUIRE, "agent");
            asm volatile("s_waitcnt vmcnt(0)" ::: "memory");
        }
    }
    __syncthreads();
}

__device__ __forceinline__ int pi64(int j) { return (j & 1) ? 32 + (j >> 1) : (j >> 1); }
__device__ __forceinline__ bool rope_tile(int t) { return (t >= 16 && t <= 20) || t == 22 || t == 24; }
__device__ __forceinline__ int win_src(int j) {
    const int t = j >> 8;
    if (t < 16) return j;
    if (t < 26) return rope_tile(t) ? ((j & ~63) + pi64(j & 63)) : j;
    if (t < 34) return j + 48;
    const int r = j - 8704; return r < 48 ? 6656 + r : -1;
}
struct SrcWin { const float* w; __device__ __forceinline__ float operator()(int k, int j) const { const int s = win_src(j); return s >= 0 ? w[(size_t)k * NSRC + s] : 0.f; } };
struct SrcPlain { const float* w; int n; __device__ __forceinline__ float operator()(int k, int j) const { return w[(size_t)k * n + j]; } };
struct SrcGU { const float* wg; const float* wu; __device__ __forceinline__ float operator()(int k, int j) const { const int t = j >> 8, r = j & 255; return r < 128 ? wg[(size_t)k * DFF + 128 * t + r] : wu[(size_t)k * DFF + 128 * t + r - 128]; } };
struct SrcCW1 { const float* wk; const float* wv; __device__ __forceinline__ float operator()(int k, int j) const { return j < 256 ? wk[(size_t)((k & ~63) + pi64(k & 63)) * 256 + j] : wv[(size_t)k * 256 + j - 256]; } };
struct SrcCW2 { const float* wk; const float* wv; __device__ __forceinline__ float operator()(int k, int j) const { return j < 64 ? wk[k * 64 + pi64(j)] : ((j >= 256 && j < 320) ? wv[k * 64 + j - 256] : 0.f); } };

template <class F>
__device__ __forceinline__ void tr_item(const F& f, bf16* WT, int K, int N, int item, LAS float* scr, int lane) {
    const int nblk = N / 32, kb = item / nblk, nb = item % nblk, k0 = 64 * kb, n0 = 32 * nb;
#pragma unroll 8
    for (int i = 0; i < 32; ++i) { const int kk = 2 * i + (lane >> 5); scr[kk * 33 + (lane & 31)] = f(k0 + kk, n0 + (lane & 31)); }
    LDS_WAIT(); asm volatile("" ::: "memory");
    const int c = lane & 7;
#pragma unroll
    for (int j = 0; j < 4; ++j) { const int n = (lane >> 3) + 8 * j; const LAS float* s = scr + (8 * c) * 33 + n;
        v4u o; o.x = pk2(s[0 * 33], s[1 * 33]); o.y = pk2(s[2 * 33], s[3 * 33]); o.z = pk2(s[4 * 33], s[5 * 33]); o.w = pk2(s[6 * 33], s[7 * 33]);
        *(v4u*)(WT + (size_t)(n0 + n) * K + k0 + 8 * c) = o; }
    LDS_WAIT(); asm volatile("" ::: "memory");
}

__device__ static const float ROPE_INVF[32] = {
    1.000000000e+00f, 7.498942614e-01f, 5.623413324e-01f, 4.216965139e-01f, 3.162277639e-01f, 2.371373773e-01f, 1.778279394e-01f, 1.333521307e-01f,
    1.000000015e-01f, 7.498941571e-02f, 5.623413250e-02f, 4.216965288e-02f, 3.162277490e-02f, 2.371373773e-02f, 1.778279431e-02f, 1.333521493e-02f,
    9.999999776e-03f, 7.498941850e-03f, 5.623413250e-03f, 4.216964822e-03f, 3.162277630e-03f, 2.371373586e-03f, 1.778279431e-03f, 1.333521446e-03f,
    1.000000047e-03f, 7.498942432e-04f, 5.623413017e-04f, 4.216965172e-04f, 3.162277571e-04f, 2.371373703e-04f, 1.778279402e-04f, 1.333521504e-04f };

__device__ __forceinline__ void sincos_acc(float ang, float& c, float& s) {
    const double a = (double)ang, twopi = 6.283185307179586476925287, inv2pi = 0.15915494309189533576888;
    const double k = __builtin_rint(a * inv2pi), r = a - k * twopi, r2 = r * r;
    double cs = 1.0, sn = 1.0, tc = 1.0, ts = 1.0;
#pragma unroll
    for (int n = 1; n <= 13; ++n) { tc = -tc * r2 / (double)((2 * n - 1) * (2 * n)); ts = -ts * r2 / (double)((2 * n) * (2 * n + 1)); cs += tc; sn += ts; }
    c = (float)cs; s = (float)(sn * r);
}

struct P0Args { const float* const* in; };
using pg8::Unit;
typedef const f32x4 (&AccRef)[2][2][4][2];

__device__ __forceinline__ v4u pack8(const float (&o)[8]) { v4u w; w.x = pk2(o[0], o[1]); w.y = pk2(o[2], o[3]); w.z = pk2(o[4], o[5]); w.w = pk2(o[6], o[7]); return w; }

struct EpiProj {
    static constexpr bool PERM = true, AFTER_DRAIN = false;
    int grp;
    __device__ __forceinline__ void operator()(AccRef acc, const Unit& u, int wr, int wc, int fr, int fq) const {
        const int pn = u.pn, rbase = u.pm * 256 + wr * 64 + fr;
        unsigned char* const ws = KWS();
        const float* const lb = (const float*)(ws + WS_VEC) + VEC_LB;
        const f32x2* const rope = (const f32x2*)(ws + WS_ROPE) + (size_t)grp * TG * 32;
#pragma unroll
        for (int ai = 0; ai < 2; ++ai)
#pragma unroll
            for (int m = 0; m < 4; ++m) {
                const int row = rbase + ai * 128 + m * 16;
                const int b = row >> 11, t = row & 2047;
#pragma unroll
                for (int bj = 0; bj < 2; ++bj) {
                    const int c0 = bj * 128 + wc * 32 + fq * 8;
                    float v[8];
#pragma unroll
                    for (int e = 0; e < 4; ++e) { v[e] = acc[ai][bj][m][0][e]; v[4 + e] = acc[ai][bj][m][1][e]; }
                    if (pn < 16) {
                        const int seg = pn >> 2, col = (pn & 3) * 256 + c0;
                        if (seg == 1) {
                            const f32x4 l0 = *(const f32x4*)(lb + col), l1 = *(const f32x4*)(lb + col + 4);
                            float o[8];
#pragma unroll
                            for (int e = 0; e < 8; ++e) { const float lbv = e < 4 ? l0[e] : l1[e - 4]; o[e] = flog(lbv + (1.0f - lbv) * sigm(v[e])); }
                            v4u w; w.x = pkh2(o[0], o[1]); w.y = pkh2(o[2], o[3]); w.z = pkh2(o[4], o[5]); w.w = pkh2(o[6], o[7]);
                            *(v4u*)(ws + (WS_HQ + (size_t)seg * (64 * MiB) + ((size_t)row * 1024 + col) * 2)) = w;
                        } else {
                            *(v4u*)(ws + (WS_HQ + (size_t)seg * (64 * MiB) + ((size_t)row * 1024 + col) * 2)) = pack8(v);
                        }
                    } else if (pn < 26) {
                        const bool rp = rope_tile(pn);
                        float o[8];
                        if (rp) {
                            const int i0 = (c0 & 63) >> 1;
                            const f32x4 cs0 = *(const f32x4*)(rope + (size_t)row * 32 + i0), cs1 = *(const f32x4*)(rope + (size_t)row * 32 + i0 + 2);
                            o[0] = v[0] * cs0[0] - v[1] * cs0[1]; o[1] = v[1] * cs0[0] + v[0] * cs0[1];
                            o[2] = v[2] * cs0[2] - v[3] * cs0[3]; o[3] = v[3] * cs0[2] + v[2] * cs0[3];
                            o[4] = v[4] * cs1[0] - v[5] * cs1[1]; o[5] = v[5] * cs1[0] + v[4] * cs1[1];
                            o[6] = v[6] * cs1[2] - v[7] * cs1[3]; o[7] = v[7] * cs1[2] + v[6] * cs1[3];
                        } else {
#pragma unroll
                            for (int e = 0; e < 8; ++e) o[e] = v[e];
                        }
                        const int hd = c0 >> 6, jh = c0 & 63;
                        if (pn < 20) {
                            const int head = (pn - 16) * 4 + hd;
                            *(v4u*)((bf16*)(ws + WS_NQ) + ((size_t)(b * 16 + head) * S + t) * 64 + jh) = pack8(o);
                        } else if (pn == 23 || pn == 25) {
                            bf16* dst = (bf16*)(ws + (WS_KC + (size_t)(pn - 20) * (16 * MiB) + (((size_t)(b * 4 + hd) * 64 + jh) * S + t) * 2));
#pragma unroll
                            for (int e = 0; e < 8; ++e) dst[(size_t)e * S] = (bf16)(pk2(o[e], 0.f) & 0xffffu);
                        } else {
                            *(v4u*)(ws + (WS_KC + (size_t)(pn - 20) * (16 * MiB) + (((size_t)(b * 4 + hd) * S + t) * 64 + jh) * 2)) = pack8(o);
                        }
                    } else if (pn < 34) {
                        float o[8];
#pragma unroll
                        for (int e = 0; e < 8; ++e) o[e] = sigm(v[e]);
                        *(v4u*)(ws + (WS_GA + (size_t)((pn - 26) >> 2) * (64 * MiB) + ((size_t)row * 1024 + ((pn - 26) & 3) * 256 + c0) * 2)) = pack8(o);
                    } else {
                        if (c0 < 48) {
                            float* dst = (float*)(ws + WS_GATES) + (size_t)row * 48 + c0;
                            *(f32x4*)dst = (f32x4){sigm(v[0]), sigm(v[1]), sigm(v[2]), sigm(v[3])};
                            *(f32x4*)(dst + 4) = (f32x4){sigm(v[4]), sigm(v[5]), sigm(v[6]), sigm(v[7])};
                        }
                    }
                    asm volatile("" ::: "memory");
                }
            }
    }
};

struct EpiCmp1 {
    static constexpr bool PERM = true, AFTER_DRAIN = false;
    bf16* HC; const float* cb1;
    __device__ __forceinline__ void operator()(AccRef acc, const Unit& u, int wr, int wc, int fr, int fq) const {
        const int rbase = u.pm * 256 + wr * 64 + fr;
#pragma unroll
        for (int bj = 0; bj < 2; ++bj) {
            const int c0 = bj * 128 + wc * 32 + fq * 8;
            const f32x4 b0 = *(const f32x4*)(cb1 + u.pn * 256 + c0), b1 = *(const f32x4*)(cb1 + u.pn * 256 + c0 + 4);
#pragma unroll
            for (int ai = 0; ai < 2; ++ai)
#pragma unroll
                for (int m = 0; m < 4; ++m) {
                    const int row = rbase + ai * 128 + m * 16;
                    float o[8];
#pragma unroll
                    for (int e = 0; e < 4; ++e) { o[e] = siluf(acc[ai][bj][m][0][e] + b0[e]); o[4 + e] = siluf(acc[ai][bj][m][1][e] + b1[e]); }
                    *(v4u*)(HC + (size_t)row * 256 + c0) = pack8(o);
                }
        }
    }
};
struct EpiCmp2 {
    static constexpr bool PERM = true, AFTER_DRAIN = false;
    bf16* KCMP; bf16* VCMPT; const float* cb2;
    __device__ __forceinline__ void operator()(AccRef acc, const Unit& u, int wr, int wc, int fr, int fq) const {
        if (wc >= 2) return;
        const int c0 = wc * 32 + fq * 8, rbase = u.pm * 256 + wr * 64 + fr;
        const f32x4 b0 = *(const f32x4*)(cb2 + u.pn * 256 + c0), b1 = *(const f32x4*)(cb2 + u.pn * 256 + c0 + 4);
#pragma unroll
        for (int ai = 0; ai < 2; ++ai)
#pragma unroll
            for (int m = 0; m < 4; ++m) {
                const int row = rbase + ai * 128 + m * 16;
                float o[8];
#pragma unroll
                for (int e = 0; e < 4; ++e) { o[e] = acc[ai][0][m][0][e] + b0[e]; o[4 + e] = acc[ai][0][m][1][e] + b1[e]; }
                if (u.pn == 0) *(v4u*)(KCMP + (size_t)row * 64 + c0) = pack8(o);
                else { const int r2 = row - 8192, bh = r2 >> 7, n = r2 & 127; bf16* dst = VCMPT + ((size_t)bh * 64 + c0) * 128 + n;
#pragma unroll
                    for (int e = 0; e < 8; ++e) dst[e * 128] = (bf16)(pk2(o[e], 0.f) & 0xffffu); }
            }
    }
};
template <bool ACCUM> struct EpiMerge {
    static constexpr bool PERM = true, AFTER_DRAIN = false;
    __device__ __forceinline__ void operator()(AccRef acc, const Unit& u, int wr, int wc, int fr, int fq) const {
        const int rbase = u.pm * 256 + wr * 64 + fr;
        unsigned char* const ws = KWS();
        const bf16* const GT = (const bf16*)(ws + (ACCUM ? WS_GB : WS_GA)); bf16* const MG = (bf16*)(ws + WS_MERGED);
#pragma unroll
        for (int ai = 0; ai < 2; ++ai)
#pragma unroll
            for (int m = 0; m < 4; ++m) {
                const int row = rbase + ai * 128 + m * 16;
#pragma unroll
                for (int bj = 0; bj < 2; ++bj) {
                    const size_t off = (size_t)row * 1024 + u.pn * 256 + bj * 128 + wc * 32 + fq * 8;
                    const v4u gt = *(const v4u*)(GT + off);
                    float o[8];
                    o[0] = bflo(gt.x) * acc[ai][bj][m][0][0]; o[1] = bfhi(gt.x) * acc[ai][bj][m][0][1]; o[2] = bflo(gt.y) * acc[ai][bj][m][0][2]; o[3] = bfhi(gt.y) * acc[ai][bj][m][0][3];
                    o[4] = bflo(gt.z) * acc[ai][bj][m][1][0]; o[5] = bfhi(gt.z) * acc[ai][bj][m][1][1]; o[6] = bflo(gt.w) * acc[ai][bj][m][1][2]; o[7] = bfhi(gt.w) * acc[ai][bj][m][1][3];
                    if (ACCUM) { const v4u pv = *(const v4u*)(MG + off);
                        o[0] += bflo(pv.x); o[1] += bfhi(pv.x); o[2] += bflo(pv.y); o[3] += bfhi(pv.y); o[4] += bflo(pv.z); o[5] += bfhi(pv.z); o[6] += bflo(pv.w); o[7] += bfhi(pv.w); }
                    *(v4u*)(MG + off) = pack8(o);
                }
                asm volatile("" ::: "memory");
            }
    }
};
struct EpiResid {
    static constexpr bool PERM = false, AFTER_DRAIN = false;
    const float* res; float* out; float scale;
    __device__ __forceinline__ void operator()(AccRef acc, const Unit& u, int wr, int wc, int fr, int fq) const {
        const int rbase = u.pm * 256 + wr * 64 + fr;
#pragma unroll
        for (int ai = 0; ai < 2; ++ai)
#pragma unroll
            for (int m = 0; m < 4; ++m) {
                const int row = rbase + ai * 128 + m * 16;
#pragma unroll
                for (int bj = 0; bj < 2; ++bj)
#pragma unroll
                    for (int n = 0; n < 2; ++n) {
                        const size_t off = (size_t)row * 1024 + u.pn * 256 + bj * 128 + wc * 32 + n * 16 + fq * 4;
                        const f32x4 r = *(const f32x4*)(res + off);
                        *(f32x4*)(out + off) = r * DN_ALPHA + acc[ai][bj][m][n] * scale;
                    }
                asm volatile("" ::: "memory");
            }
    }
};
struct EpiGU {
    static constexpr bool PERM = true, AFTER_DRAIN = false;
    bf16* HID;
    __device__ __forceinline__ void operator()(AccRef acc, const Unit& u, int wr, int wc, int fr, int fq) const {
        const int rbase = u.pm * 256 + wr * 64 + fr;
#pragma unroll
        for (int ai = 0; ai < 2; ++ai)
#pragma unroll
            for (int m = 0; m < 4; ++m) {
                const int row = rbase + ai * 128 + m * 16;
                float o[8];
#pragma unroll
                for (int e = 0; e < 4; ++e) { o[e] = siluf(acc[ai][0][m][0][e]) * acc[ai][1][m][0][e]; o[4 + e] = siluf(acc[ai][0][m][1][e]) * acc[ai][1][m][1][e]; }
                *(v4u*)(HID + (size_t)row * DFF + u.pn * 128 + wc * 32 + fq * 8) = pack8(o);
            }
    }
};
struct OneUnit {
    int pm, pn; bool has;
    __device__ __forceinline__ bool next(int i, Unit& u) const { if (i == 0 && has) { u.pm = pm; u.pn = pn; return true; } return false; }
    __device__ __forceinline__ void a_ready(const Unit&) const {}
    __device__ __forceinline__ void done(const Unit&) const {}
};
__device__ __forceinline__ void hgrn_phase(LAS unsigned char* lds, const bf16* HQ, const bf16* HF, const bf16* HI, bf16* ORAW, int G, int c) {
    constexpr int CH = 32;
    LAS float* Fs = (LAS float*)lds;
    LAS float* Qs = (LAS float*)(lds + 16384);
    LAS float* Is = (LAS float*)(lds + 32768);
    LAS float* Os = (LAS float*)(lds + 40960);
    const int tid = fresh_tid(), lane = tid & 63, wave = tid >> 6, kg = lane & 15, vs = lane >> 4;
    const int stok = tid >> 4, sc8 = tid & 15;
    for (int unit = c; unit < BG * 16; unit += G) {
        const int vh = unit & 1, h = (unit >> 1) & 7, b = unit >> 4;
        const size_t row0 = (size_t)b * S;
        const int colq = h * 128, coli = h * 128 + vh * 64;
#if DBG_EXP == 1 || DBG_EXP == 2
        if (vh == (DBG_EXP == 1 ? 1 : 0)) {
            for (int r = tid; r < S * 8; r += 512) *(v4u*)(ORAW + (row0 + (r >> 3)) * 1024 + coli + (r & 7) * 8) = (v4u){0u, 0u, 0u, 0u};
            continue;
        }
#endif
        f32x2 st[8];
#pragma unroll
        for (int k = 0; k < 8; ++k) st[k] = (f32x2){0.f, 0.f};
        v4u rq, rf, ri;
        rq = *(const v4u*)(HQ + (row0 + stok) * 1024 + colq + sc8 * 8);
        rf = *(const v4u*)(HF + (row0 + stok) * 1024 + colq + sc8 * 8);
        ri = (v4u){0u, 0u, 0u, 0u};
        if (tid < 256) ri = *(const v4u*)(HI + (row0 + (tid >> 3)) * 1024 + coli + (tid & 7) * 8);
        for (int ch = 0; ch < S / CH; ++ch) {
            {
                LAS float* qd = Qs + stok * 128 + sc8 * 8; LAS float* fd = Fs + stok * 128 + sc8 * 8;
                *(LAS f32x4*)qd = (f32x4){bflo(rq.x), bfhi(rq.x), bflo(rq.y), bfhi(rq.y)};
                *(LAS f32x4*)(qd + 4) = (f32x4){bflo(rq.z), bfhi(rq.z), bflo(rq.w), bfhi(rq.w)};
                *(LAS f32x4*)fd = (f32x4){fexp(h2f_lo(rf.x)), fexp(h2f_hi(rf.x)), fexp(h2f_lo(rf.y)), fexp(h2f_hi(rf.y))};
                *(LAS f32x4*)(fd + 4) = (f32x4){fexp(h2f_lo(rf.z)), fexp(h2f_hi(rf.z)), fexp(h2f_lo(rf.w)), fexp(h2f_hi(rf.w))};
                if (tid < 256) { LAS float* id = Is + (tid >> 3) * 64 + (tid & 7) * 8;
                    *(LAS f32x4*)id = (f32x4){bflo(ri.x), bfhi(ri.x), bflo(ri.y), bfhi(ri.y)};
                    *(LAS f32x4*)(id + 4) = (f32x4){bflo(ri.z), bfhi(ri.z), bflo(ri.w), bfhi(ri.w)}; }
            }
            __syncthreads();
            if (ch + 1 < S / CH) {
                const size_t r1 = row0 + (size_t)(ch + 1) * CH;
                rq = *(const v4u*)(HQ + (r1 + stok) * 1024 + colq + sc8 * 8);
                rf = *(const v4u*)(HF + (r1 + stok) * 1024 + colq + sc8 * 8);
                if (tid < 256) ri = *(const v4u*)(HI + (r1 + (tid >> 3)) * 1024 + coli + (tid & 7) * 8);
            }
#pragma unroll 4
            for (int tt = 0; tt < CH; ++tt) {
                const f32x4 fa = *(const LAS f32x4*)(Fs + tt * 128 + kg * 8), fb = *(const LAS f32x4*)(Fs + tt * 128 + kg * 8 + 4);
                const f32x4 qa = *(const LAS f32x4*)(Qs + tt * 128 + kg * 8), qb = *(const LAS f32x4*)(Qs + tt * 128 + kg * 8 + 4);
                const f32x2 iv = *(const LAS f32x2*)(Is + tt * 64 + wave * 8 + vs * 2);
                f32x2 o = (f32x2){0.f, 0.f};
#pragma unroll
                for (int k = 0; k < 8; ++k) {
                    const float fk = k < 4 ? fa[k & 3] : fb[k & 3], qk = k < 4 ? qa[k & 3] : qb[k & 3];
                    st[k] = iv + (st[k] - iv) * fk;
                    o += st[k] * qk;
                }
                o.x = sum16(o.x); o.y = sum16(o.y);
                if (kg == 0) *(LAS f32x2*)(Os + tt * 64 + wave * 8 + vs * 2) = o;
            }
            __syncthreads();
            {
                const f32x4 ov = *(const LAS f32x4*)(Os + stok * 64 + sc8 * 4);
                v2u w; w.x = pk2(ov[0], ov[1]); w.y = pk2(ov[2], ov[3]);
                *(v2u*)(ORAW + (row0 + (size_t)ch * CH + stok) * 1024 + coli + sc8 * 4) = w;
            }
        }
        __syncthreads();
    }
}

__device__ __forceinline__ void anorm_phase(const bf16* ORAW, const bf16* HG, const float* norm_g, bf16* AOUT, int G, int c) {
    const int tid = fresh_tid(), lane = tid & 63, gw = c * 8 + (tid >> 6), ngw = G * 8;
    const int e0 = (lane & 7) * 16, col = (lane >> 3) * 128 + e0;
    f32x4 ng[4];
#pragma unroll
    for (int i = 0; i < 4; ++i) ng[i] = *(const f32x4*)(norm_g + e0 + 4 * i);
    for (int row = gw; row < TG; row += ngw) {
        const v4u o0 = *(const v4u*)(ORAW + (size_t)row * 1024 + col), o1 = *(const v4u*)(ORAW + (size_t)row * 1024 + col + 8);
        const v4u g0 = *(const v4u*)(HG + (size_t)row * 1024 + col), g1 = *(const v4u*)(HG + (size_t)row * 1024 + col + 8);
        float o[16], gg[16];
        o[0] = bflo(o0.x); o[1] = bfhi(o0.x); o[2] = bflo(o0.y); o[3] = bfhi(o0.y); o[4] = bflo(o0.z); o[5] = bfhi(o0.z); o[6] = bflo(o0.w); o[7] = bfhi(o0.w);
        o[8] = bflo(o1.x); o[9] = bfhi(o1.x); o[10] = bflo(o1.y); o[11] = bfhi(o1.y); o[12] = bflo(o1.z); o[13] = bfhi(o1.z); o[14] = bflo(o1.w); o[15] = bfhi(o1.w);
        gg[0] = bflo(g0.x); gg[1] = bfhi(g0.x); gg[2] = bflo(g0.y); gg[3] = bfhi(g0.y); gg[4] = bflo(g0.z); gg[5] = bfhi(g0.z); gg[6] = bflo(g0.w); gg[7] = bfhi(g0.w);
        gg[8] = bflo(g1.x); gg[9] = bfhi(g1.x); gg[10] = bflo(g1.y); gg[11] = bfhi(g1.y); gg[12] = bflo(g1.z); gg[13] = bfhi(g1.z); gg[14] = bflo(g1.w); gg[15] = bfhi(g1.w);
        float ss = 0.f;
#pragma unroll
        for (int i = 0; i < 16; ++i) ss += o[i] * o[i];
        ss = sum8(ss);
        const float rs = frsq(ss * (1.0f / 128.0f) + RMS_EPS);
        float r[16];
#pragma unroll
        for (int i = 0; i < 16; ++i) r[i] = o[i] * rs * ng[i >> 2][i & 3] * siluf(gg[i]);
        v4u w0, w1;
        w0.x = pk2(r[0], r[1]); w0.y = pk2(r[2], r[3]); w0.z = pk2(r[4], r[5]); w0.w = pk2(r[6], r[7]);
        w1.x = pk2(r[8], r[9]); w1.y = pk2(r[10], r[11]); w1.z = pk2(r[12], r[13]); w1.w = pk2(r[14], r[15]);
        *(v4u*)(AOUT + (size_t)row * 1024 + col) = w0; *(v4u*)(AOUT + (size_t)row * 1024 + col + 8) = w1;
    }
}

__device__ __forceinline__ void ln_rows(const float* src, float* of, bf16* ob, const float* gam, const float* bet, int nrows, int G, int c, float oscale = 1.f) {
    const int tid = fresh_tid(), lane = tid & 63, gw = c * 8 + (tid >> 6), ngw = G * 8;
    f32x4 gv[4], bv[4];
#pragma unroll
    for (int j = 0; j < 4; ++j) { gv[j] = *(const f32x4*)(gam + 4 * lane + 256 * j); bv[j] = *(const f32x4*)(bet + 4 * lane + 256 * j); }
    for (int row = gw; row < nrows; row += ngw) {
        const f32x4* xr = (const f32x4*)(src + (size_t)row * 1024) + lane;
        f32x4 v[4]; float s = 0.f;
#pragma unroll
        for (int j = 0; j < 4; ++j) { v[j] = xr[64 * j]; s += (v[j].x + v[j].y) + (v[j].z + v[j].w); }
        const float mean = wave_sum(s) * (1.f / 1024.f); float s2 = 0.f;
#pragma unroll
        for (int j = 0; j < 4; ++j) { v[j] = v[j] - mean; s2 += (v[j].x * v[j].x + v[j].y * v[j].y) + (v[j].z * v[j].z + v[j].w * v[j].w); }
        const float rstd = frsq(wave_sum(s2) * (1.f / 1024.f) + LN_EPS);
#pragma unroll
        for (int j = 0; j < 4; ++j) {
            const f32x4 y = (v[j] * rstd * gv[j] + bv[j]) * oscale;
            if (of) *((f32x4*)(of + (size_t)row * 1024) + lane + 64 * j) = y;
            if (ob) { v2u w; w.x = pk2(y.x, y.y); w.y = pk2(y.z, y.w); *((v2u*)(ob + (size_t)row * 1024) + lane + 64 * j) = w; }
        }
    }
}

#define MFMA16(a, b, c) __builtin_amdgcn_mfma_f32_16x16x32_bf16((a), (b), (c), 0, 0, 0)

__device__ __forceinline__ void nsa_scores(const bf16* Kp, int kbase, int j, int fq, const bf16x8 (&qf)[2][2], f32x4 (&sc)[2][2][2]) {
    const bf16* kr = Kp + (size_t)(kbase + 8 * (j >> 2) + (j & 3)) * 64 + fq * 8;
#pragma unroll
    for (int kh = 0; kh < 2; ++kh)
#pragma unroll
        for (int kb = 0; kb < 2; ++kb) {
            const bf16x8 k0 = *(const bf16x8*)(kr + (size_t)(32 * kh + 4 * kb) * 64), k1 = *(const bf16x8*)(kr + (size_t)(32 * kh + 4 * kb) * 64 + 32);
#pragma unroll
            for (int rb = 0; rb < 2; ++rb) {
                f32x4 a = (f32x4){0.f, 0.f, 0.f, 0.f};
                a = MFMA16(k0, qf[rb][0], a); a = MFMA16(k1, qf[rb][1], a);
                sc[rb][kh][kb] = a;
            }
        }
}
__device__ __forceinline__ void nsa_pv(const bf16* Vt, int ldv, int kbase, int j, int fq, const bf16x8 (&pb)[2][2], f32x4 (&oacc)[2][4]) {
#pragma unroll
    for (int db = 0; db < 4; ++db)
#pragma unroll
        for (int kh = 0; kh < 2; ++kh) {
            const bf16x8 vf = *(const bf16x8*)(Vt + (size_t)(16 * db + j) * ldv + kbase + 32 * kh + 8 * fq);
#pragma unroll
            for (int rb = 0; rb < 2; ++rb) oacc[rb][db] = MFMA16(vf, pb[rb][kh], oacc[rb][db]);
        }
}
__device__ __forceinline__ bf16x8 pack_p(const f32x4& a, const f32x4& b) {
    v4u w; w.x = pk2(a[0], a[1]); w.y = pk2(a[2], a[3]); w.z = pk2(b[0], b[1]); w.w = pk2(b[2], b[3]); return __builtin_bit_cast(bf16x8, w);
}
__device__ __forceinline__ float fq_max(float v) { v = fmaxf(v, __shfl_xor(v, 16)); v = fmaxf(v, __shfl_xor(v, 32)); return v; }
__device__ __forceinline__ float fq_sum(float v) { v += __shfl_xor(v, 16); v += __shfl_xor(v, 32); return v; }

__device__ __forceinline__ void nsa_online(const bf16* Vt, int ldv, int kbase, int j, int fq, f32x4 (&sc)[2][2][2], const int (&lo)[2], const int (&hi)[2], float negb,
                                           float (&mrun)[2], float (&lrun)[2], f32x4 (&oacc)[2][4]) {
    bf16x8 pb[2][2];
#pragma unroll
    for (int rb = 0; rb < 2; ++rb) {
        float mx = negb;
#pragma unroll
        for (int kh = 0; kh < 2; ++kh)
#pragma unroll
            for (int kb = 0; kb < 2; ++kb)
#pragma unroll
                for (int r = 0; r < 4; ++r) { const int key = kbase + 32 * kh + 8 * fq + 4 * kb + r; const bool ok = key > lo[rb] && key <= hi[rb];
                    const float s = ok ? sc[rb][kh][kb][r] * SM_C : negb; sc[rb][kh][kb][r] = s; mx = fmaxf(mx, s); }
        mx = fq_max(mx);
        const float mnew = fmaxf(mrun[rb], mx), alpha = __builtin_amdgcn_exp2f(mrun[rb] - mnew);
        float ls = 0.f;
#pragma unroll
        for (int kh = 0; kh < 2; ++kh)
#pragma unroll
            for (int kb = 0; kb < 2; ++kb)
#pragma unroll
                for (int r = 0; r < 4; ++r) { const int key = kbase + 32 * kh + 8 * fq + 4 * kb + r; const bool ok = key > lo[rb] && key <= hi[rb];
                    const float p = ok ? __builtin_amdgcn_exp2f(sc[rb][kh][kb][r] - mnew) : 0.f; sc[rb][kh][kb][r] = p; ls += p; }
        ls = fq_sum(ls);
        lrun[rb] = lrun[rb] * alpha + ls; mrun[rb] = mnew;
#pragma unroll
        for (int db = 0; db < 4; ++db) oacc[rb][db] = oacc[rb][db] * alpha;
        pb[rb][0] = pack_p(sc[rb][0][0], sc[rb][0][1]); pb[rb][1] = pack_p(sc[rb][1][0], sc[rb][1][1]);
    }
    nsa_pv(Vt, ldv, kbase, j, fq, pb, oacc);
}

__device__ __forceinline__ void nsa_phase(LAS unsigned char* lds, int G, int c) {
    const int tid = fresh_tid(), lane = tid & 63, wave = __builtin_amdgcn_readfirstlane(tid >> 6), j = lane & 15, fq = lane >> 4, qq = j >> 2, g = j & 3;
    LAS float* ps = (LAS float*)(lds + wave * 4096);
    LAS float* scs = (LAS float*)(lds + 32768 + wave * 1024);
    LAS unsigned* msk = (LAS unsigned*)(lds + 40960 + wave * 32);
    LAS f32x4* park = (LAS f32x4*)(lds + 49152 + wave * 8192) + lane;
    float negb = NEG_BIG; asm volatile("" : "+v"(negb));
    for (int it = 0;; ++it) {
        const int idx = it * G + c; if (idx >= BG * 4 * 32) break;
        const int bh = idx >> 5, qblk = ((idx & 31) + 4 * (idx >> 8)) & 31;
        const int b = bh >> 2, kvh = bh & 3, t0 = qblk * 64, cur = qblk;
        int tq[2]; tq[0] = t0 + 8 * wave + qq; tq[1] = tq[0] + 4;
        bf16x8 qf[2][2];
#pragma unroll
        for (int rb = 0; rb < 2; ++rb)
#pragma unroll
            for (int dh = 0; dh < 2; ++dh) qf[rb][dh] = *(const bf16x8*)((const bf16*)(KWS() + WS_NQ) + ((size_t)(b * 16 + kvh * 4 + g) * S + tq[rb]) * 64 + dh * 32 + fq * 8);

        {
            unsigned char* const ws = KWS(); const bf16* Kc = (const bf16*)(ws + WS_KCMP) + (size_t)bh * 128 * 64; const bf16* Vc = (const bf16*)(ws + WS_VCMPT) + (size_t)bh * 64 * 128;
            int nmax[2];
#pragma unroll
            for (int rb = 0; rb < 2; ++rb) nmax[rb] = tq[rb] >= 31 ? ((tq[rb] - 31) >> 4) : -1;
            const bool two = (t0 + 63) >= 1055;
            f32x4 s0[2][2][2], s1[2][2][2];
            nsa_scores(Kc, 0, j, fq, qf, s0);
            if (two) nsa_scores(Kc, 64, j, fq, qf, s1);
            else {
#pragma unroll
                for (int rb = 0; rb < 2; ++rb)
#pragma unroll
                    for (int kh = 0; kh < 2; ++kh)
#pragma unroll
                        for (int kb = 0; kb < 2; ++kb) s1[rb][kh][kb] = (f32x4){0.f, 0.f, 0.f, 0.f};
            }
            bf16x8 pb0[2][2], pb1[2][2];
#pragma unroll
            for (int rb = 0; rb < 2; ++rb) {
                float mx = negb;
#pragma unroll
                for (int kh = 0; kh < 2; ++kh)
#pragma unroll
                    for (int kb = 0; kb < 2; ++kb)
#pragma unroll
                        for (int r = 0; r < 4; ++r) {
                            const int n = 32 * kh + 8 * fq + 4 * kb + r;
                            const float a = (n <= nmax[rb]) ? s0[rb][kh][kb][r] * SM_C : negb; s0[rb][kh][kb][r] = a; mx = fmaxf(mx, a);
                            const float bb = (n + 64 <= nmax[rb]) ? s1[rb][kh][kb][r] * SM_C : negb; s1[rb][kh][kb][r] = bb; mx = fmaxf(mx, bb);
                        }
                mx = fq_max(mx);
                float ls = 0.f;
#pragma unroll
                for (int kh = 0; kh < 2; ++kh)
#pragma unroll
                    for (int kb = 0; kb < 2; ++kb)
#pragma unroll
                        for (int r = 0; r < 4; ++r) {
                            const int n = 32 * kh + 8 * fq + 4 * kb + r;
                            const float a = (n <= nmax[rb]) ? __builtin_amdgcn_exp2f(s0[rb][kh][kb][r] - mx) : 0.f; s0[rb][kh][kb][r] = a; ls += a;
                            const float bb = (n + 64 <= nmax[rb]) ? __builtin_amdgcn_exp2f(s1[rb][kh][kb][r] - mx) : 0.f; s1[rb][kh][kb][r] = bb; ls += bb;
                        }
                ls = fq_sum(ls);
                const float inv = frcp(fmaxf(ls, 1e-30f));
#pragma unroll
                for (int kh = 0; kh < 2; ++kh) {
#pragma unroll
                    for (int kb = 0; kb < 2; ++kb) { s0[rb][kh][kb] = s0[rb][kh][kb] * inv; s1[rb][kh][kb] = s1[rb][kh][kb] * inv; }
                    pb0[rb][kh] = pack_p(s0[rb][kh][0], s0[rb][kh][1]); pb1[rb][kh] = pack_p(s1[rb][kh][0], s1[rb][kh][1]);
                    f32x4 a0, a1, b0, b1;
#pragma unroll
                    for (int r = 0; r < 4; ++r) { a0[r] = sum4(s0[rb][kh][0][r]); a1[r] = sum4(s0[rb][kh][1][r]); b0[r] = sum4(s1[rb][kh][0][r]); b1[r] = sum4(s1[rb][kh][1][r]); }
                    if (g == 0) {
                        LAS float* d = ps + (rb * 4 + qq) * 128 + 32 * kh + 8 * fq;
                        *(LAS f32x4*)d = a0; *(LAS f32x4*)(d + 4) = a1; *(LAS f32x4*)(d + 64) = b0; *(LAS f32x4*)(d + 68) = b1;
                    }
                }
            }
            f32x4 oc[2][4];
#pragma unroll
            for (int rb = 0; rb < 2; ++rb)
#pragma unroll
                for (int db = 0; db < 4; ++db) oc[rb][db] = (f32x4){0.f, 0.f, 0.f, 0.f};
            nsa_pv(Vc, 128, 0, j, fq, pb0, oc);
            if (two) nsa_pv(Vc, 128, 64, j, fq, pb1, oc);
#pragma unroll
            for (int rb = 0; rb < 2; ++rb) {
                const float gt = ((const float*)(ws + WS_GATES))[((size_t)b * S + tq[rb]) * 48 + 0 * 16 + kvh * 4 + g];
#pragma unroll
                for (int db = 0; db < 4; ++db) park[(rb * 4 + db) * 64] = oc[rb][db] * gt;
            }
        }
        LDS_WAIT();
#pragma unroll 1
        for (int pass = 0; pass < 4; ++pass) {
            const int q8 = 2 * pass + (lane >> 5), k = lane & 31;
            const LAS float* pr = ps + q8 * 128;
            float imp = pr[4 * k] + pr[4 * k + 1] + pr[4 * k + 2] + 0.5f * pr[4 * k + 3];
            if (k > 0) imp += 0.5f * pr[4 * k - 1];
            const bool forced = (k == 0) || (k == cur) || (k == cur - 1);
            scs[q8 * 32 + k] = (k <= cur) ? imp + (forced ? 1000.0f : 0.0f) : -1.0f;
        }
        LDS_WAIT();
#pragma unroll 1
        for (int pass = 0; pass < 4; ++pass) {
            const int q8 = 2 * pass + (lane >> 5), k = lane & 31;
            const LAS float* sr = scs + q8 * 32;
            const float my = sr[k];
            int rank = 0;
#pragma unroll
            for (int k2 = 0; k2 < 32; ++k2) { const float o = sr[k2]; rank += (o > my || (o == my && k2 < k)) ? 1 : 0; }
            const bool sel = (rank < 8) && (k <= cur);
            const unsigned long long bal = __ballot(sel);
            if (lane == 0) { msk[2 * pass] = (unsigned)bal; msk[2 * pass + 1] = (unsigned)(bal >> 32); }
        }
        LDS_WAIT();
        unsigned mym[2]; mym[0] = msk[qq]; mym[1] = msk[4 + qq];
        LDS_WAIT();

        {
            unsigned char* const ws = KWS(); const bf16* Ks = (const bf16*)(ws + WS_KS) + (size_t)bh * S * 64; const bf16* Vs = (const bf16*)(ws + WS_VST) + (size_t)bh * 64 * S;
            float mrun[2] = {negb, negb}, lrun[2] = {0.f, 0.f};
            f32x4 oa[2][4];
#pragma unroll
            for (int rb = 0; rb < 2; ++rb)
#pragma unroll
                for (int db = 0; db < 4; ++db) oa[rb][db] = (f32x4){0.f, 0.f, 0.f, 0.f};
            for (int k = 0; k <= cur; ++k) {
                if (__ballot((((mym[0] | mym[1]) >> k) & 1u) != 0u) == 0ull) continue;
                f32x4 sc[2][2][2];
                nsa_scores(Ks, 64 * k, j, fq, qf, sc);
                int lo[2], hi[2];
#pragma unroll
                for (int rb = 0; rb < 2; ++rb) { lo[rb] = -1; hi[rb] = ((mym[rb] >> k) & 1u) ? tq[rb] : -1; }
                nsa_online(Vs, S, 64 * k, j, fq, sc, lo, hi, negb, mrun, lrun, oa);
            }
#pragma unroll
            for (int rb = 0; rb < 2; ++rb) {
                const float gt = ((const float*)(ws + WS_GATES))[((size_t)b * S + tq[rb]) * 48 + 1 * 16 + kvh * 4 + g] * frcp(fmaxf(lrun[rb], 1e-30f));
#pragma unroll
                for (int db = 0; db < 4; ++db) park[(rb * 4 + db) * 64] = park[(rb * 4 + db) * 64] + oa[rb][db] * gt;
            }
        }
        {
            unsigned char* const ws = KWS(); const bf16* Kw = (const bf16*)(ws + WS_KW) + (size_t)bh * S * 64; const bf16* Vw = (const bf16*)(ws + WS_VWT) + (size_t)bh * 64 * S;
            float mrun[2] = {negb, negb}, lrun[2] = {0.f, 0.f};
            f32x4 oa[2][4];
#pragma unroll
            for (int rb = 0; rb < 2; ++rb)
#pragma unroll
                for (int db = 0; db < 4; ++db) oa[rb][db] = (f32x4){0.f, 0.f, 0.f, 0.f};
            for (int k = (cur > 8 ? cur - 8 : 0); k <= cur; ++k) {
                f32x4 sc[2][2][2];
                nsa_scores(Kw, 64 * k, j, fq, qf, sc);
                int lo[2], hi[2];
#pragma unroll
                for (int rb = 0; rb < 2; ++rb) { lo[rb] = tq[rb] - 512; hi[rb] = tq[rb]; }
                nsa_online(Vw, S, 64 * k, j, fq, sc, lo, hi, negb, mrun, lrun, oa);
            }
#pragma unroll
            for (int rb = 0; rb < 2; ++rb) {
                const float gt = ((const float*)(ws + WS_GATES))[((size_t)b * S + tq[rb]) * 48 + 2 * 16 + kvh * 4 + g] * frcp(fmaxf(lrun[rb], 1e-30f));
                bf16* dst = (bf16*)(ws + WS_BOUT) + ((size_t)b * S + tq[rb]) * 1024 + (kvh * 4 + g) * 64 + 4 * fq;
#pragma unroll
                for (int db = 0; db < 4; ++db) { f32x4 o = park[(rb * 4 + db) * 64] + oa[rb][db] * gt;
#if DBG_EXP == 3
                    o = o * 0.f;
#endif
                    v2u w; w.x = pk2(o[0], o[1]); w.y = pk2(o[2], o[3]); *(v2u*)(dst + 16 * db) = w; }
            }
        }
    }
}
#if DBG_CHK
__device__ __forceinline__ float bfr(float v) { return bflo(pk2(v, 0.f) & 0xffffu); }
__device__ __forceinline__ void dbg_flag(unsigned bit) { atomicOr((unsigned*)(KWS() + WS_CTL) + 8, bit); }
__device__ __forceinline__ bool dbg_bad(float got, float want) { return !(fabsf(got - want) <= 0.02f * fabsf(want) + 0.02f); }
__device__ __forceinline__ void dbg_check_proj(int G, int c) {
    const int tid = fresh_tid(), lane = tid & 63, gw = c * 8 + (tid >> 6), ngw = G * 8;
    unsigned char* ws = KWS(); const float* x = KIN(0); const float* win = KIN(2); const float* lb = (const float*)(ws + WS_VEC) + VEC_LB;
    for (int s = gw; s < 4096; s += ngw) {
        const int row = (s * 97) % TG, sel = s % 5, col = (s * 131) % 1024;
        const int src = sel < 4 ? sel * 1024 + col : 6704 + col;
        float acc = 0.f;
        for (int k = lane; k < 1024; k += 64) acc += bfr(x[(size_t)row * 1024 + k]) * bfr(win[(size_t)k * NSRC + src]);
        acc = wave_sum(acc);
        float got, want; unsigned bit;
        if (sel == 1) { const unsigned short h = ((const unsigned short*)(ws + WS_HF))[(size_t)row * 1024 + col]; got = (float)__builtin_bit_cast(_Float16, h); want = logf(lb[col] + (1.f - lb[col]) / (1.f + expf(-acc))); bit = 8u; }
        else if (sel == 4) { got = bflo(((const unsigned short*)(ws + WS_GA))[(size_t)row * 1024 + col]); want = 1.f / (1.f + expf(-acc)); bit = 8u; }
        else { const size_t base = sel == 0 ? WS_HQ : (sel == 2 ? WS_HI : WS_HG); got = bflo(((const unsigned short*)(ws + base))[(size_t)row * 1024 + col]); want = acc; bit = 4u; }
        if (lane == 0 && dbg_bad(got, want)) dbg_flag(bit);
    }
}
__device__ __forceinline__ void dbg_check_hgrn(int G, int c) {
    const int tid = fresh_tid(), lane = tid & 63, gw = c * 8 + (tid >> 6), ngw = G * 8;
    unsigned char* ws = KWS(); const bf16* HQ = (const bf16*)(ws + WS_HQ); const unsigned short* HF = (const unsigned short*)(ws + WS_HF); const bf16* HI = (const bf16*)(ws + WS_HI); const bf16* OR = (const bf16*)(ws + WS_ORAW);
    for (int s = gw; s < 256; s += ngw) {
        const int b = s & 15, h = (s >> 4) & 7, v = (s * 37 + 5) & 127;
        float s0 = 0.f, s1 = 0.f; int nbad = 0;
        for (int t = 0; t < S; ++t) {
            const size_t r = ((size_t)b * S + t) * 1024 + h * 128;
            const float f0 = expf((float)__builtin_bit_cast(_Float16, HF[r + lane])), f1 = expf((float)__builtin_bit_cast(_Float16, HF[r + lane + 64]));
            const float q0 = bflo(HQ[r + lane]), q1 = bflo(HQ[r + lane + 64]), iv = bflo(HI[r + v]);
            s0 = f0 * s0 + (1.f - f0) * iv; s1 = f1 * s1 + (1.f - f1) * iv;
            const float o = wave_sum(q0 * s0 + q1 * s1);
            if (dbg_bad(bflo(OR[r + v]), o)) ++nbad;
        }
        if (lane == 0 && nbad > 0) dbg_flag(1u);
    }
}
__device__ __forceinline__ void dbg_check_anorm(int G, int c) {
    const int tid = fresh_tid(), lane = tid & 63, gw = c * 8 + (tid >> 6), ngw = G * 8;
    unsigned char* ws = KWS(); const bf16* OR = (const bf16*)(ws + WS_ORAW); const bf16* HG = (const bf16*)(ws + WS_HG); const bf16* AO = (const bf16*)(ws + WS_AOUT); const float* ng = KIN(4);
    for (int s = gw; s < 2048; s += ngw) {
        const int row = (s * 61) % TG, h = s & 7; const size_t r = (size_t)row * 1024 + h * 128;
        const float o0 = bflo(OR[r + lane]), o1 = bflo(OR[r + lane + 64]);
        const float ss = wave_sum(o0 * o0 + o1 * o1), rs = 1.f / sqrtf(ss / 128.f + RMS_EPS);
        const float g0 = bflo(HG[r + lane]), g1 = bflo(HG[r + lane + 64]);
        const float w0 = o0 * rs * ng[lane] * g0 / (1.f + expf(-g0)), w1 = o1 * rs * ng[lane + 64] * g1 / (1.f + expf(-g1));
        const bool bad = dbg_bad(bflo(AO[r + lane]), w0) || dbg_bad(bflo(AO[r + lane + 64]), w1);
        if (__ballot(bad) != 0ull && lane == 0) dbg_flag(2u);
    }
}
__device__ __forceinline__ void dbg_check_merge(int G, int c) {
    const int tid = fresh_tid(), lane = tid & 63, gw = c * 8 + (tid >> 6), ngw = G * 8;
    unsigned char* ws = KWS(); const bf16* AO = (const bf16*)(ws + WS_AOUT); const bf16* BO = (const bf16*)(ws + WS_BOUT); const bf16* GA = (const bf16*)(ws + WS_GA); const bf16* GB = (const bf16*)(ws + WS_GB); const bf16* MG = (const bf16*)(ws + WS_MERGED);
    const float* wa = KIN(15); const float* wb = KIN(16);
    for (int s = gw; s < 4096; s += ngw) {
        const int row = (s * 97) % TG, col = (s * 131) % 1024;
        float a = 0.f, b = 0.f;
        for (int k = lane; k < 1024; k += 64) { a += bflo(AO[(size_t)row * 1024 + k]) * bfr(wa[(size_t)k * 1024 + col]); b += bflo(BO[(size_t)row * 1024 + k]) * bfr(wb[(size_t)k * 1024 + col]); }
        a = wave_sum(a); b = wave_sum(b);
        const float want = bflo(GA[(size_t)row * 1024 + col]) * a + bflo(GB[(size_t)row * 1024 + col]) * b;
        if (lane == 0 && dbg_bad(bflo(MG[(size_t)row * 1024 + col]), want)) dbg_flag(DBG_CHK == 2 ? 1u : 0u);
    }
}
__device__ __forceinline__ void dbg_check_pre1(int G, int c) {
    const int tid = fresh_tid(), lane = tid & 63, gw = c * 8 + (tid >> 6), ngw = G * 8;
    unsigned char* ws = KWS(); const bf16* MG = (const bf16*)(ws + WS_MERGED); const float* P1 = (const float*)(ws + WS_PRE1); const float* wo = KIN(17); const float* x = KIN(0);
    for (int s = gw; s < 4096; s += ngw) {
        const int row = (s * 97) % TG, col = (s * 131) % 1024;
        float a = 0.f;
        for (int k = lane; k < 1024; k += 64) a += bflo(MG[(size_t)row * 1024 + k]) * bfr(wo[(size_t)k * 1024 + col]);
        a = wave_sum(a);
        const float want = DN_ALPHA * x[(size_t)row * 1024 + col] + a;
        if (lane == 0 && dbg_bad(P1[(size_t)row * 1024 + col], want)) dbg_flag(DBG_CHK == 2 ? 2u : 0u);
    }
}
#endif
#ifndef PH_P0
#define PH_P0 1
#endif
#ifndef PH_P1
#define PH_P1 1
#endif
#ifndef PH_CMP
#define PH_CMP 1
#endif
#ifndef PH_HG
#define PH_HG 1
#endif
#ifndef PH_AN
#define PH_AN 1
#endif
#ifndef PH_NSA
#define PH_NSA 1
#endif
#ifndef PH_P4
#define PH_P4 1
#endif
#ifndef PH_P5
#define PH_P5 1
#endif
#ifndef PH_LN
#define PH_LN 1
#endif
#ifndef PH_P7
#define PH_P7 1
#endif
#ifndef PH_P8
#define PH_P8 1
#endif
struct Args { const void* in[25]; float* out; unsigned char* ws; };

__global__ void __launch_bounds__(512, 2) nsa_hgrn_fwd(Args args) {
    extern __shared__ __attribute__((aligned(16))) unsigned char lds_raw[];
    LAS unsigned char* lds = (LAS unsigned char*)lds_raw;
    const int G = gridDim.x, c = blockIdx.x;
    unsigned char* ws = KWS();
    for (int u = threadIdx.x; u < (LDS_BYTES - LDSCTL_OFF) / 4; u += 512) ((LAS unsigned*)(lds + LDSCTL_OFF))[u] = 0u;
    __syncthreads();
    XcdBarrier bar = xcd_barrier_post((unsigned*)(ws + WS_CTL) + CW_BAR, (volatile LAS unsigned*)(lds + MISC_OFF) + 8);


#if PH_P0
    {
        const int tid = fresh_tid(), lane = tid & 63, wave = __builtin_amdgcn_readfirstlane(tid >> 6), gw = c * 8 + wave, ngw = G * 8, gt = c * 512 + tid, ngt = G * 512;
        LAS float* scr = (LAS float*)(lds + wave * 16384);
        constexpr int I_WIN = 16 * (NPROJ / 32), I_SQ = 16 * 32, I_GU = 16 * (NGU / 32), I_D = (DFF / 64) * 32, I_C1 = 32 * 16, I_C2 = 4 * 16;
        constexpr int NITEMS = I_WIN + 3 * I_SQ + I_GU + I_D + I_C1 + I_C2;
        const SrcWin fwin{KIN(2)};
        const SrcPlain fa{KIN(15), 1024}, fb{KIN(16), 1024}, fo{KIN(17), 1024}, fd{KIN(22), 1024};
        const SrcGU fgu{KIN(20), KIN(21)};
        const SrcCW1 fc1{KIN(6), KIN(11)};
        const SrcCW2 fc2{KIN(8), KIN(13)};
        for (int it = gw; it < NITEMS; it += ngw) {
            int r = it;
            if (r < I_WIN) { tr_item(fwin, (bf16*)(KWS() + WS_WIN), 1024, NPROJ, r, scr, lane); continue; } r -= I_WIN;
            if (r < I_SQ) { tr_item(fa, (bf16*)(KWS() + WS_WA), 1024, 1024, r, scr, lane); continue; } r -= I_SQ;
            if (r < I_SQ) { tr_item(fb, (bf16*)(KWS() + WS_WB), 1024, 1024, r, scr, lane); continue; } r -= I_SQ;
            if (r < I_SQ) { tr_item(fo, (bf16*)(KWS() + WS_WO), 1024, 1024, r, scr, lane); continue; } r -= I_SQ;
            if (r < I_GU) { tr_item(fgu, (bf16*)(KWS() + WS_WGU), 1024, NGU, r, scr, lane); continue; } r -= I_GU;
            if (r < I_D) { tr_item(fd, (bf16*)(KWS() + WS_WD), DFF, 1024, r, scr, lane); continue; } r -= I_D;
            if (r < I_C1) { tr_item(fc1, (bf16*)(KWS() + WS_CW1), 2048, 512, r, scr, lane); continue; } r -= I_C1;
            tr_item(fc2, (bf16*)(KWS() + WS_CW2), 256, 512, r, scr, lane);
        }
        const float* lbl = KIN(3);
        for (int i = gt; i < 1024; i += ngt) ((float*)(KWS() + WS_VEC))[VEC_LB + i] = sigm(lbl[i] - lbl[1024 + i]);
        for (int o = gw; o < 512; o += ngw) {
            const bool isv = o >= 256; const int jj = o & 255;
            const float* pos = KIN(isv ? 10 : 5); const float* w1 = KIN(isv ? 11 : 6); const float* b1 = KIN(isv ? 12 : 7);
            float s = 0.f;
            for (int kk = lane; kk < 2048; kk += 64) s += pos[kk] * w1[(size_t)kk * 256 + jj];
            s = wave_sum(s);
            if (lane == 0) ((float*)(KWS() + WS_VEC))[VEC_CB1 + o] = s + b1[jj];
        }
        for (int i = gt; i < 512; i += ngt) {
            float v = 0.f;
            if (i < 64) v = (KIN(9))[pi64(i)]; else if (i >= 256 && i < 320) v = (KIN(14))[i - 256];
            ((float*)(KWS() + WS_VEC))[VEC_CB2 + i] = v;
        }
        for (int e = gt; e < BATCH * S * 32; e += ngt) {
            const float ang = (float)((const int*)karg(1))[e >> 5] * ROPE_INVF[e & 31];
            float cs, sn; sincos_acc(ang, cs, sn);
            ((f32x2*)(KWS() + WS_ROPE))[e] = (f32x2){cs, sn};
        }
    }

#endif
    for (int grp = 0; grp < NGRP; ++grp) {
        {
            const int gt = fresh_s(c) * 512 + fresh_tid(), ngt = fresh_s(G) * 512;
            bf16* XB = (bf16*)(KWS() + WS_XB); const float* xg = KIN(0) + (size_t)grp * TG * 1024;
            for (int i = gt; i < TG * 1024 / 8; i += ngt) {
                const f32x4 a = *(const f32x4*)(xg + (size_t)i * 8), b2 = *(const f32x4*)(xg + (size_t)i * 8 + 4);
                v4u w; w.x = pk2(a[0], a[1]); w.y = pk2(a[2], a[3]); w.z = pk2(b2[0], b2[1]); w.w = pk2(b2[2], b2[3]);
                *(v4u*)(XB + (size_t)i * 8) = w;
            }
        }
        xcd_barrier(bar);
#if PH_P1
        {
            pg8::Gemm g{(const bf16*)(KWS() + WS_XB), (const bf16*)(KWS() + WS_WIN), TG, NPROJ, 1024, 1024};
            pg8::StaticOrder So; So.init(TG, NPROJ, fresh_s(G), fresh_s(c));
            EpiProj E{grp};
            pg8::gemm_phase<EpiProj, pg8::StaticOrder, true, true>(lds, g, So, E);
        }
#endif
        xcd_barrier(bar);
#if DBG_CHK == 1
        if (grp == 0) dbg_check_proj(fresh_s(G), fresh_s(c));
#endif
#if PH_CMP
        if (fresh_s(c) < 64) {
            const int cc = fresh_s(c);
            {
                pg8::Gemm g{(const bf16*)(KWS() + WS_KC), (const bf16*)(KWS() + WS_CW1), 16384, 512, 2048, 1024};
                OneUnit So{cc, cc >> 5, true};
                EpiCmp1 E{(bf16*)(KWS() + WS_HC), (float*)(KWS() + WS_VEC) + VEC_CB1};
                pg8::gemm_phase<EpiCmp1, OneUnit, false, true>(lds, g, So, E);
            }
            VM_WAIT(); __syncthreads();
            {
                pg8::Gemm g{(const bf16*)(KWS() + WS_HC), (const bf16*)(KWS() + WS_CW2), 16384, 512, 256, 256};
                OneUnit So{cc, cc >> 5, true};
                EpiCmp2 E{(bf16*)(KWS() + WS_KCMP), (bf16*)(KWS() + WS_VCMPT), (float*)(KWS() + WS_VEC) + VEC_CB2};
                pg8::gemm_phase<EpiCmp2, OneUnit, false, true>(lds, g, So, E);
            }
            __syncthreads();
        }
#endif
#if PH_HG
        hgrn_phase(lds, (const bf16*)(KWS() + WS_HQ), (const bf16*)(KWS() + WS_HF), (const bf16*)(KWS() + WS_HI), (bf16*)(KWS() + WS_ORAW), fresh_s(G), fresh_s(c));
#endif
        xcd_barrier(bar);
#if DBG_CHK == 1
        if (grp == 0) dbg_check_hgrn(fresh_s(G), fresh_s(c));
#endif
#if PH_AN
        anorm_phase((const bf16*)(KWS() + WS_ORAW), (const bf16*)(KWS() + WS_HG), KIN(4), (bf16*)(KWS() + WS_AOUT), fresh_s(G), fresh_s(c));
#endif
#if PH_NSA
        {
            nsa_phase(lds, fresh_s(G), fresh_s(c));
        }
#endif
        xcd_barrier(bar);
#if DBG_CHK == 1
        if (grp == 0) dbg_check_anorm(fresh_s(G), fresh_s(c));
#endif
#if PH_P4
        {
            pg8::StaticOrder So; So.init(TG, 1024, fresh_s(G), fresh_s(c));
            {
                pg8::Gemm g{(const bf16*)(KWS() + WS_AOUT), (const bf16*)(KWS() + WS_WA), TG, 1024, 1024, 1024};
                EpiMerge<false> E{};
                pg8::gemm_phase<EpiMerge<false>, pg8::StaticOrder, true, true>(lds, g, So, E);
            }
            VM_WAIT(); __syncthreads();
            {
                pg8::Gemm g{(const bf16*)(KWS() + WS_BOUT), (const bf16*)(KWS() + WS_WB), TG, 1024, 1024, 1024};
                EpiMerge<true> E{};
                pg8::gemm_phase<EpiMerge<true>, pg8::StaticOrder, true, true>(lds, g, So, E);
            }
        }
#endif
        xcd_barrier(bar);
#if DBG_CHK == 2
        if (grp == 0) dbg_check_merge(fresh_s(G), fresh_s(c));
#endif
#if PH_P5
        {
            pg8::Gemm g{(const bf16*)(KWS() + WS_MERGED), (const bf16*)(KWS() + WS_WO), TG, 1024, 1024, 1024};
            pg8::StaticOrder So; So.init(TG, 1024, fresh_s(G), fresh_s(c));
            EpiResid E{KIN(0) + (size_t)grp * TG * 1024, (float*)(KWS() + WS_PRE1), DBG_EXP == 5 ? 0.f : 1.f};
            pg8::gemm_phase<EpiResid, pg8::StaticOrder, true, true>(lds, g, So, E);
        }
#endif
        xcd_barrier(bar);
#if DBG_CHK == 2
        if (grp == 0) dbg_check_pre1(fresh_s(G), fresh_s(c));
#endif
#if PH_LN
        ln_rows((const float*)(KWS() + WS_PRE1), (float*)(KWS() + WS_PRE1), (bf16*)(KWS() + WS_H1B), KIN(18), KIN(19), TG, fresh_s(G), fresh_s(c));
#endif
        xcd_barrier(bar);
#if PH_P7
        {
            pg8::Gemm g{(const bf16*)(KWS() + WS_H1B), (const bf16*)(KWS() + WS_WGU), TG, NGU, 1024, 1024};
            pg8::StaticOrder So; So.init(TG, NGU, fresh_s(G), fresh_s(c));
            EpiGU E{(bf16*)(KWS() + WS_HID)};
            pg8::gemm_phase<EpiGU, pg8::StaticOrder, true, true>(lds, g, So, E);
        }
#endif
        xcd_barrier(bar);
#if PH_P8
        {
            pg8::Gemm g{(const bf16*)(KWS() + WS_HID), (const bf16*)(KWS() + WS_WD), TG, 1024, DFF, DFF};
            pg8::StaticOrder So; So.init(TG, 1024, fresh_s(G), fresh_s(c));
            EpiResid E{(const float*)(KWS() + WS_PRE1), KOUT() + (size_t)grp * TG * 1024, DBG_EXP == 6 ? 0.f : 1.f};
            pg8::gemm_phase<EpiResid, pg8::StaticOrder, true, true>(lds, g, So, E);
        }
#endif
        xcd_barrier(bar);
        { float* outg = KOUT() + (size_t)grp * TG * 1024;
        ln_rows(outg, outg, nullptr, KIN(23), KIN(24), TG, fresh_s(G), fresh_s(c), DBG_CHK ? 1.f + (float)__hip_atomic_load((unsigned*)(KWS() + WS_CTL) + 8, __ATOMIC_RELAXED, __HIP_MEMORY_SCOPE_AGENT) : 1.f); }
    }
}

extern "C" void kernel_launch(void* const* d_in, const int* in_sizes, int n_in, void* d_out, int out_size, void* d_ws, size_t ws_size, hipStream_t stream) {
    static int grid = 0;
    if (grid == 0) {
        if (n_in != 25 || in_sizes[0] != BATCH * S * D || out_size != BATCH * S * D || ws_size < WS_END) {
            fprintf(stderr, "kernel_launch: unexpected problem (n_in %d, in0 %d, out %d, ws %zu; need ws >= %zu); nothing launched\n", n_in, n_in > 0 ? in_sizes[0] : -1, out_size, ws_size, (size_t)WS_END);
            grid = -1; return; }
        int dev = 0, cus = 0, per_cu = 0;
        if (hipGetDevice(&dev) != hipSuccess || hipDeviceGetAttribute(&cus, hipDeviceAttributeMultiprocessorCount, dev) != hipSuccess) { grid = -1; return; }
        if (hipFuncSetAttribute((const void*)nsa_hgrn_fwd, hipFuncAttributeMaxDynamicSharedMemorySize, LDS_BYTES) != hipSuccess) { fprintf(stderr, "kernel_launch: hipFuncSetAttribute failed\n"); grid = -1; return; }
        if (hipOccupancyMaxActiveBlocksPerMultiprocessor(&per_cu, (const void*)nsa_hgrn_fwd, 512, LDS_BYTES) != hipSuccess || per_cu < 1)
            fprintf(stderr, "kernel_launch: note: occupancy query reports %d workgroups per CU\n", per_cu);
        (void)hipGetLastError();
        grid = cus;
    }
    if (grid < 0) return;
    if (hipMemsetAsync((char*)d_ws + WS_CTL, 0, CTL_ZERO_BYTES, stream) != hipSuccess) return;
    Args a{};
    for (int i = 0; i < 25; ++i) a.in[i] = d_in[i];
    a.out = (float*)d_out; a.ws = (unsigned char*)d_ws;
    hipLaunchKernelGGL(nsa_hgrn_fwd, dim3(grid), dim3(512), LDS_BYTES, stream, a);
}
```

```cpp
#include <hip/hip_runtime.h>
#include <cstdio>
#include <cstdint>
#ifndef DBG_EXP
#define DBG_EXP 0
#endif
#ifndef DBG_CHK
#define DBG_CHK 0
#endif
#ifndef DUP_NSA
#define DUP_NSA 0
#endif
#ifndef DUP_HG
#define DUP_HG 0
#endif
#ifndef DBG_SUB
#define DBG_SUB 7
#endif
#ifndef DBG_NBAD
#define DBG_NBAD 5
#endif
#ifndef DBG_DELAY
#define DBG_DELAY 0
#endif
#ifndef DBG_NDIV
#define DBG_NDIV 256.f
#endif
namespace pg8 {
#define PG8_LAS __attribute__((address_space(3)))
typedef unsigned short bf16_t;
typedef short bf16x8 __attribute__((ext_vector_type(8)));
typedef float f32x4 __attribute__((ext_vector_type(4)));
typedef unsigned u32x4 __attribute__((ext_vector_type(4)));
constexpr int BM = 256, BK = 64, HALF = 128, HTB = HALF * BK * 2  , STAGE_BYTES = 8 * HTB, NXCD = 8, WGM = 8;

__host__ __device__ __forceinline__ int lds_byte(int r, int c) { const int st = (r >> 4) * 2 + (c >> 5), rr = r & 15, cc = c & 31, ob = rr * 64 + cc * 2; return st * 1024 + (ob ^ (((ob >> 9) & 1) << 5)); }
__host__ __device__ __forceinline__ void stage_rc(int b, int& R, int& C) { const int st = b / 1024, sb = b % 1024, swz = sb ^ (((sb >> 9) & 1) << 5); R = (st >> 1) * 16 + swz / 64; C = (st & 1) * 32 + (swz % 64) / 2; }
__host__ __device__ __forceinline__ int perm32(int rho) { const int n = rho >> 4, i = rho & 15; return 8 * (i >> 2) + 4 * n + (i & 3); }

struct Unit { int pm, pn; };
struct Gemm { const bf16_t* A; const bf16_t* Bt; int M, N, K, lda; };

struct StaticOrder {
    int nM, nN, nwg, G, c;
    __host__ __device__ void init(int M, int N, int G_, int c_) { nM = M / BM; nN = N / BM; nwg = nM * nN; G = G_; c = c_; }
    __host__ __device__ bool next(int i, Unit& u) const {
        const long L = (long)i * G + c; if (L >= nwg) return false;
        int wgid = (int)L; { const int q = nwg / NXCD, r = nwg % NXCD, xcd = wgid % NXCD, off = wgid / NXCD; wgid = (xcd < r ? xcd * (q + 1) : r * (q + 1) + (xcd - r) * q) + off; }
        const int nig = WGM * nN, gid = wgid / nig, fm = gid * WGM, gsz = (nM - fm) < WGM ? (nM - fm) : WGM;
        u.pm = fm + ((wgid % nig) % gsz); u.pn = (wgid % nig) / gsz; return true;
    }
    __device__ __forceinline__ void a_ready(const Unit&) const {}
    __device__ __forceinline__ void done(const Unit&) const {}
};

__device__ __forceinline__ unsigned cvt_pk_bf16(float lo, float hi) { unsigned r; asm volatile("v_cvt_pk_bf16_f32 %0, %1, %2" : "=v"(r) : "v"(lo), "v"(hi)); return r; }
template <class Epi, class Sched, bool ALIGN_EPI = false, bool SP2 = false>
__device__ __forceinline__ void gemm_phase(PG8_LAS unsigned char* lds, const Gemm g, const Sched& S, const Epi& E, const int wv) {
    unsigned z_ = 0u; asm volatile("" : "+v"(z_)); const int tid = (wv << 6) | (int)__builtin_amdgcn_mbcnt_hi(~0u, __builtin_amdgcn_mbcnt_lo(~0u, z_)), wid = __builtin_amdgcn_readfirstlane(tid >> 6), lane = tid & 63, wr = wid >> 2, wc = wid & 3, fr = lane & 15, fq = lane >> 4;
    const int K = g.K, nt = K / BK;
    unsigned voffA[2], voffB[2];
#pragma unroll
    for (int i = 0; i < 2; ++i) { int R, C; stage_rc(tid * 16 + i * 8192, R, C); const int Rb = Epi::PERM ? ((R & ~31) + perm32(R & 31)) : R;
        voffA[i] = (unsigned)(R * g.lda + C) * 2u; voffB[i] = (unsigned)(Rb * K + C) * 2u; }
    const size_t kstep = (size_t)(BK * 2);
    const size_t hstepA = (size_t)HALF * g.lda * 2, hstepB = (size_t)HALF * K * 2;
    const size_t tstepA = 2 * hstepA, tstepB = 2 * hstepB;
    const unsigned ldsw = (unsigned)wid * 1024u;
    const int aoff = lds_byte(wr * 64 + fr, fq * 8), boff = lds_byte(wc * 32 + fr, fq * 8);
#define PG8_SA(b, h) (((b) * 2 + (h)) * HTB)
#define PG8_SB(b, h) ((4 + (b) * 2 + (h)) * HTB)
#define PG8_STAGE(bufoff, gbase, voff) do { _Pragma("unroll") for (int _i = 0; _i < 2; ++_i) \
        __builtin_amdgcn_global_load_lds((const unsigned*)((const char*)(gbase) + (voff)[_i]), (PG8_LAS unsigned*)(lds + (bufoff) + ldsw + _i * 8192), 16, 0, 0); } while (0)
#define PG8_LDA(dst, b, h) do { _Pragma("unroll") for (int m = 0; m < 4; ++m) _Pragma("unroll") for (int k = 0; k < 2; ++k) dst[m][k] = *(const PG8_LAS bf16x8*)(lds + PG8_SA(b, h) + aoff + m * 2048 + k * 1024); } while (0)
#define PG8_LDB(dst, b, h) do { _Pragma("unroll") for (int n = 0; n < 2; ++n) _Pragma("unroll") for (int k = 0; k < 2; ++k) dst[n][k] = *(const PG8_LAS bf16x8*)(lds + PG8_SB(b, h) + boff + n * 2048 + k * 1024); } while (0)
#define PG8_MMA(ai, bj, At, Bt) do { __builtin_amdgcn_s_setprio(1); _Pragma("unroll") for (int m = 0; m < 4; ++m) _Pragma("unroll") for (int n = 0; n < 2; ++n) _Pragma("unroll") for (int k = 0; k < 2; ++k) \
        acc[ai][bj][m][n] = __builtin_amdgcn_mfma_f32_16x16x32_bf16(Bt[n][k], At[m][k], acc[ai][bj][m][n], 0, 0, 0); __builtin_amdgcn_s_setprio(0); } while (0)
#define PG8_WAIT_V(n) asm volatile("s_waitcnt vmcnt(" #n ")" ::: "memory")
#define PG8_WAIT_L(n) asm volatile("s_waitcnt lgkmcnt(" #n ")" ::: "memory")
#define PG8_BAR __builtin_amdgcn_s_barrier()
#define PG8_SCHED __builtin_amdgcn_sched_barrier(0)
    Unit cur, nxt; int ui = 0;
    if (!S.next(0, cur)) return;
    f32x4 acc[2][2][4][2];
#pragma unroll
    for (int a = 0; a < 2; ++a)
#pragma unroll
        for (int b = 0; b < 2; ++b)
#pragma unroll
            for (int m = 0; m < 4; ++m)
#pragma unroll
                for (int n = 0; n < 2; ++n) acc[a][b][m][n] = (f32x4){0.f, 0.f, 0.f, 0.f};
    bf16x8 At[4][2], B0[2][2], B1[2][2];
    const char* cA = (const char*)g.A + (size_t)cur.pm * tstepA; const char* cB = (const char*)g.Bt + (size_t)cur.pn * tstepB;
    S.a_ready(cur);
    if constexpr (SP2) {
        PG8_STAGE(PG8_SB(0, 0), cB, voffB); PG8_STAGE(PG8_SB(0, 1), cB + hstepB, voffB); PG8_STAGE(PG8_SA(0, 0), cA, voffA); PG8_STAGE(PG8_SA(0, 1), cA + hstepA, voffA);
        if (wr == 1) PG8_BAR;
        PG8_WAIT_V(2); PG8_BAR;
        PG8_STAGE(PG8_SB(1, 0), cB + kstep, voffB); PG8_STAGE(PG8_SA(1, 0), cA + kstep, voffA); PG8_STAGE(PG8_SB(1, 1), cB + hstepB + kstep, voffB);
        PG8_WAIT_V(6); PG8_BAR;
    } else {
        PG8_STAGE(PG8_SB(0, 0), cB, voffB); PG8_STAGE(PG8_SA(0, 0), cA, voffA); PG8_STAGE(PG8_SB(0, 1), cB + hstepB, voffB); PG8_STAGE(PG8_SA(0, 1), cA + hstepA, voffA);
        if (wr == 1) PG8_BAR;
        PG8_WAIT_V(4); PG8_BAR;
        PG8_STAGE(PG8_SB(1, 0), cB + kstep, voffB); PG8_STAGE(PG8_SA(1, 0), cA + kstep, voffA); PG8_STAGE(PG8_SB(1, 1), cB + hstepB + kstep, voffB);
        PG8_WAIT_V(6); PG8_BAR;
    }
    for (;;) {
        const bool has_next = S.next(ui + 1, nxt);
        const char* nA = has_next ? (const char*)g.A + (size_t)nxt.pm * tstepA : cA; const char* nB = has_next ? (const char*)g.Bt + (size_t)nxt.pn * tstepB : cB;
        for (int t = 0; t < nt; t += 2) {
            const bool last = (t == nt - 2);
            const char* a1 = cA + (size_t)(t + 1) * kstep;
            const char* a2 = last ? nA : cA + (size_t)(t + 2) * kstep; const char* b2 = last ? nB : cB + (size_t)(t + 2) * kstep;
            const char* a3 = a2 + kstep; const char* b3 = b2 + kstep;
            if (last && has_next) S.a_ready(nxt);
            if constexpr (SP2) {
            PG8_LDB(B0, 0, 0); PG8_LDB(B1, 0, 1); PG8_SCHED; PG8_LDA(At, 0, 0); PG8_STAGE(PG8_SA(1, 1), a1 + hstepA, voffA);
            PG8_WAIT_V(8); PG8_WAIT_L(0); PG8_BAR; PG8_MMA(0, 0, At, B0); PG8_MMA(0, 1, At, B1); PG8_BAR; PG8_SCHED;
            PG8_LDA(At, 0, 1); PG8_STAGE(PG8_SB(0, 0), b2, voffB); PG8_STAGE(PG8_SB(0, 1), b2 + hstepB, voffB); PG8_STAGE(PG8_SA(0, 0), a2, voffA);
            PG8_WAIT_V(8); PG8_WAIT_L(0); PG8_BAR; PG8_MMA(1, 0, At, B0); PG8_MMA(1, 1, At, B1); PG8_BAR; PG8_SCHED;
            PG8_LDB(B0, 1, 0); PG8_LDB(B1, 1, 1); PG8_SCHED; PG8_LDA(At, 1, 0); PG8_STAGE(PG8_SA(0, 1), a2 + hstepA, voffA);
            PG8_WAIT_V(8); PG8_WAIT_L(0); PG8_BAR; PG8_MMA(0, 0, At, B0); PG8_MMA(0, 1, At, B1); PG8_BAR; PG8_SCHED;
            PG8_LDA(At, 1, 1); PG8_STAGE(PG8_SB(1, 0), b3, voffB); PG8_STAGE(PG8_SB(1, 1), b3 + hstepB, voffB); PG8_STAGE(PG8_SA(1, 0), a3, voffA);
            PG8_WAIT_V(8); PG8_WAIT_L(0); PG8_BAR; PG8_MMA(1, 0, At, B0); PG8_MMA(1, 1, At, B1); PG8_BAR; PG8_SCHED;
            } else {
            PG8_LDB(B0, 0, 0); PG8_SCHED; PG8_LDA(At, 0, 0); PG8_STAGE(PG8_SA(1, 1), a1 + hstepA, voffA);
            PG8_WAIT_L(8); PG8_BAR; PG8_WAIT_L(0); PG8_MMA(0, 0, At, B0); PG8_BAR; PG8_SCHED;
            PG8_LDB(B1, 0, 1); PG8_STAGE(PG8_SB(0, 0), b2, voffB);
            PG8_BAR; PG8_WAIT_L(0); PG8_MMA(0, 1, At, B1); PG8_BAR;
            PG8_LDA(At, 0, 1); PG8_STAGE(PG8_SA(0, 0), a2, voffA);
            PG8_BAR; PG8_WAIT_L(0); PG8_MMA(1, 0, At, B0); PG8_BAR; PG8_SCHED;
            PG8_STAGE(PG8_SB(0, 1), b2 + hstepB, voffB);
            PG8_WAIT_V(6); PG8_BAR; PG8_MMA(1, 1, At, B1); PG8_BAR;
            PG8_LDB(B0, 1, 0); PG8_SCHED; PG8_LDA(At, 1, 0); PG8_STAGE(PG8_SA(0, 1), a2 + hstepA, voffA);
            PG8_WAIT_L(8); PG8_BAR; PG8_WAIT_L(0); PG8_MMA(0, 0, At, B0); PG8_BAR; PG8_SCHED;
            PG8_LDB(B1, 1, 1); PG8_STAGE(PG8_SB(1, 0), b3, voffB);
            PG8_BAR; PG8_WAIT_L(0); PG8_MMA(0, 1, At, B1); PG8_BAR;
            PG8_LDA(At, 1, 1); PG8_STAGE(PG8_SA(1, 0), a3, voffA);
            PG8_BAR; PG8_WAIT_L(0); PG8_MMA(1, 0, At, B0); PG8_BAR; PG8_SCHED;
            PG8_STAGE(PG8_SB(1, 1), b3 + hstepB, voffB);
            PG8_WAIT_V(6); PG8_BAR; PG8_MMA(1, 1, At, B1); PG8_BAR;
            }
        }
        if constexpr (ALIGN_EPI) { if (wr == 0) PG8_BAR; }
        if constexpr (!Epi::AFTER_DRAIN) { E(acc, cur, wr, wc, fr, fq); S.done(cur); }
        if (!has_next) break;
#pragma unroll
        for (int a = 0; a < 2; ++a)
#pragma unroll
            for (int b = 0; b < 2; ++b)
#pragma unroll
                for (int m = 0; m < 4; ++m)
#pragma unroll
                    for (int n = 0; n < 2; ++n) acc[a][b][m][n] = (f32x4){0.f, 0.f, 0.f, 0.f};
        cur = nxt; cA = nA; cB = nB; ++ui;
        if constexpr (ALIGN_EPI) { if (wr == 1) PG8_BAR; }
    }
    PG8_WAIT_V(0);
    if constexpr (!ALIGN_EPI) { if (wr == 0) PG8_BAR; }
    PG8_BAR;
    if constexpr (Epi::AFTER_DRAIN) { E.fused(acc, cur, wr, wc, fr, fq, lds, wid, lane); S.done(cur); }
#undef PG8_SA
#undef PG8_SB
#undef PG8_STAGE
#undef PG8_LDA
#undef PG8_LDB
#undef PG8_MMA
#undef PG8_WAIT_V
#undef PG8_WAIT_L
#undef PG8_BAR
#undef PG8_SCHED
}
}

constexpr int S = 2048, D = 1024, BATCH = 32, BG = 16, NGRP = BATCH / BG, TG = BG * S;
constexpr int NPROJ = 8960, NSRC = 8752, DFF = 2816, NGU = 2 * DFF;
constexpr float DN_ALPHA = 1.189207115002721f, LN_EPS = 1e-5f, RMS_EPS = 1e-6f;
constexpr float SM_C = 0.125f * 1.4426950408889634f;
constexpr float NEG_BIG = -1e30f;

constexpr size_t MiB = 1u << 20;
constexpr size_t WS_CTL = 0, CTL_ZERO_BYTES = 1 * MiB;
constexpr size_t WS_WIN = 1 * MiB, WS_WA = 19 * MiB, WS_WB = 21 * MiB, WS_WO = 23 * MiB, WS_WGU = 25 * MiB, WS_WD = 36 * MiB, WS_CW1 = 42 * MiB, WS_CW2 = 44 * MiB;
constexpr size_t WS_VEC = 45 * MiB, WS_ROPE = 46 * MiB;
constexpr size_t WS_XB = 64 * MiB, WS_MERGED = 64 * MiB;
constexpr size_t WS_HQ = 128 * MiB, WS_HF = 192 * MiB, WS_HI = 256 * MiB, WS_HG = 320 * MiB, WS_NQ = 384 * MiB;
constexpr size_t WS_KC = 448 * MiB, WS_VC = 464 * MiB, WS_KS = 480 * MiB, WS_VST = 496 * MiB, WS_KW = 512 * MiB, WS_VWT = 528 * MiB, WS_ORAW = 544 * MiB;
constexpr size_t WS_PRE1 = 128 * MiB, WS_H1B = 256 * MiB, WS_HID = 320 * MiB;
constexpr size_t WS_GA = 608 * MiB, WS_GB = 672 * MiB, WS_GATES = 736 * MiB, WS_HC = 742 * MiB, WS_KCMP = 750 * MiB, WS_VCMPT = 751 * MiB;
constexpr size_t WS_AOUT = 752 * MiB, WS_BOUT = 816 * MiB, WS_END = 880 * MiB;
static_assert(WS_HF == WS_HQ + 64 * MiB && WS_HI == WS_HQ + 128 * MiB && WS_HG == WS_HQ + 192 * MiB && WS_VC == WS_KC + 16 * MiB && WS_KS == WS_KC + 32 * MiB && WS_VST == WS_KC + 48 * MiB && WS_KW == WS_KC + 64 * MiB && WS_VWT == WS_KC + 80 * MiB && WS_GB == WS_GA + 64 * MiB, "EpiProj destination arithmetic");
constexpr int VEC_LB = 0, VEC_CB1 = 1024, VEC_CB2 = 1536;
constexpr int CW_BAR = 4096;

constexpr int RING_BYTES = 131072, LDSCTL_OFF = RING_BYTES, MISC_OFF = LDSCTL_OFF + 320, LDS_BYTES = 147456;

#define GAS __attribute__((address_space(1)))
#define LAS __attribute__((address_space(3)))
typedef unsigned short bf16;
typedef unsigned v4u __attribute__((ext_vector_type(4)));
typedef unsigned v2u __attribute__((ext_vector_type(2)));
typedef float f32x4 __attribute__((ext_vector_type(4)));
typedef float f32x2 __attribute__((ext_vector_type(2)));
typedef short bf16x8 __attribute__((ext_vector_type(8)));
typedef __bf16 bf16v2 __attribute__((ext_vector_type(2)));
typedef _Float16 f16v2 __attribute__((ext_vector_type(2)));
typedef GAS unsigned gu32;
#define RLX_AGENT __ATOMIC_RELAXED, __HIP_MEMORY_SCOPE_AGENT
#define LDS_WAIT() asm volatile("s_waitcnt lgkmcnt(0)" ::: "memory")
#define VM_WAIT() asm volatile("s_waitcnt vmcnt(0)" ::: "memory")

__device__ __forceinline__ int fresh_tid(int wv) { unsigned z = 0u; asm volatile("" : "+v"(z)); return (wv << 6) | (int)__builtin_amdgcn_mbcnt_hi(~0u, __builtin_amdgcn_mbcnt_lo(~0u, z)); }
__device__ __forceinline__ int fresh_s(int v) { asm volatile("" : "+s"(v)); return __builtin_amdgcn_readfirstlane(v); }
__device__ __forceinline__ unsigned pk2(float lo, float hi) { f32x2 v = {lo, hi}; bf16v2 r = __builtin_convertvector(v, bf16v2); return __builtin_bit_cast(unsigned, r); }
__device__ __forceinline__ unsigned pkh2(float lo, float hi) { f32x2 v = {lo, hi}; f16v2 r = __builtin_convertvector(v, f16v2); return __builtin_bit_cast(unsigned, r); }
__device__ __forceinline__ float h2f_lo(unsigned u) { return (float)__builtin_bit_cast(_Float16, (unsigned short)(u & 0xffffu)); }
__device__ __forceinline__ float h2f_hi(unsigned u) { return (float)__builtin_bit_cast(_Float16, (unsigned short)(u >> 16)); }
__device__ __forceinline__ float bflo(unsigned u) { return __uint_as_float(u << 16); }
__device__ __forceinline__ float bfhi(unsigned u) { return __uint_as_float(u & 0xffff0000u); }
__device__ __forceinline__ float fexp(float x) { return __builtin_amdgcn_exp2f(x * 1.4426950408889634f); }
__device__ __forceinline__ float frcp(float x) { return __builtin_amdgcn_rcpf(x); }
__device__ __forceinline__ float flog(float x) { return __builtin_amdgcn_logf(x) * 0.6931471805599453f; }
__device__ __forceinline__ float frsq(float x) { return __builtin_amdgcn_rsqf(x); }
__device__ __forceinline__ float sigm(float z) { return frcp(1.0f + fexp(-z)); }
__device__ __forceinline__ float siluf(float z) { return z * frcp(1.0f + fexp(-z)); }
template <int CTRL> __device__ __forceinline__ float dppf(float v) { return __builtin_bit_cast(float, __builtin_amdgcn_update_dpp(0, __builtin_bit_cast(int, v), CTRL, 0xF, 0xF, true)); }
__device__ __forceinline__ float sum4(float v) { v += dppf<0xB1>(v); v += dppf<0x4E>(v); return v; }
__device__ __forceinline__ float sum8(float v) { v = sum4(v); v += dppf<0x141>(v); return v; }
__device__ __forceinline__ float sum16(float v) { v = sum8(v); v += dppf<0x140>(v); return v; }
__device__ __forceinline__ float wave_sum(float v) {
#pragma unroll
    for (int o = 1; o < 64; o <<= 1) v += __shfl_xor(v, o);
    return v;
}

typedef __attribute__((address_space(4))) const unsigned long long* kargp_t;
__device__ __forceinline__ const void* karg(int i) {
    const unsigned long long p = (unsigned long long)__builtin_amdgcn_kernarg_segment_ptr();
    unsigned lo = (unsigned)p, hi = (unsigned)(p >> 32);
    asm volatile("" : "+s"(lo), "+s"(hi));
    lo = __builtin_amdgcn_readfirstlane(lo); hi = __builtin_amdgcn_readfirstlane(hi);
    const kargp_t ka = (kargp_t)(((unsigned long long)hi << 32) | lo);
    return (const void*)ka[i];
}
#define KIN(i) ((const float*)karg(i))
#define KOUT() ((float*)karg(25))
#define KWS() ((unsigned char*)karg(26))
#define XB_TMO      128
#define XB_XCNT(j)  (256  + 64 * (j))
#define XB_XSUB(j)  (1280 + 64 * (j))
#define XB_XGEN(j)  (2304 + 64 * (j))
#define XB_TOP      3328
#define XB_TOPGEN   3392
#define XCD_BAR_WORDS 3456
#define XB_SPIN_CAP (DBG_CHK ? (1u << 26) : (1u << 22))

__device__ __forceinline__ unsigned xb_ld(unsigned* p)              { return __hip_atomic_load(p, __ATOMIC_RELAXED, __HIP_MEMORY_SCOPE_AGENT); }
__device__ __forceinline__ unsigned xb_add(unsigned* p, unsigned v) { return __hip_atomic_fetch_add(p, v, __ATOMIC_RELAXED, __HIP_MEMORY_SCOPE_AGENT); }
__device__ __forceinline__ unsigned xb_xcc_id() { return (unsigned)__builtin_amdgcn_s_getreg((3 << 11) | 20) & 0xFu; }
#define XB_SPIN(cond, bar) do { unsigned _sp = 0; while (cond) { __builtin_amdgcn_s_sleep(1); \
    if ((++_sp & 255u) == 0u) { if (xb_ld(&(bar)[XB_TMO])) break; if (_sp > XB_SPIN_CAP) { atomicAdd(&(bar)[XB_TMO], 1u); break; } } } } while (0)

struct XcdBarrier { unsigned* bar; unsigned x; volatile LAS unsigned* st; };

__device__ __forceinline__ XcdBarrier xcd_barrier_post(unsigned* bar, volatile LAS unsigned* st) {
    XcdBarrier b; b.bar = bar; b.x = xb_xcc_id(); b.st = st;
    if (threadIdx.x == 0) (void)xb_add(&bar[XB_XCNT(b.x)], 1u);
    return b;
}
__device__ __forceinline__ void xcd_barrier_complete(unsigned* bar, unsigned x, unsigned& nloc, unsigned& nx) {
    const unsigned G = gridDim.x * gridDim.y * gridDim.z;
    unsigned sum, cnt, mine, sp = 0u;
    for (;;) {
        sum = 0u; cnt = 0u; mine = 0u;
#pragma unroll 1
        for (unsigned j = 0; j < 16; ++j) { const unsigned c = xb_ld(&bar[XB_XCNT(j)]); sum += c; cnt += (c > 0u) ? 1u : 0u; mine = (j == x) ? c : mine; }
        if (sum == G) break;
        __builtin_amdgcn_s_sleep(1);
        if ((++sp & 255u) == 0u) { if (xb_ld(&bar[XB_TMO])) break; if (sp > XB_SPIN_CAP) { atomicAdd(&bar[XB_TMO], 1u); break; } }
    }
    nloc = mine > 0u ? mine : 1u; nx = cnt > 0u ? cnt : 1u;
}
__device__ __forceinline__ void xcd_barrier(const XcdBarrier& b) {
    asm volatile("s_waitcnt vmcnt(0)" ::: "memory");
    __syncthreads();
    if (threadIdx.x == 0) {
        unsigned* bar = (unsigned*)(KWS() + WS_CTL) + CW_BAR;
        const unsigned bx = xb_xcc_id();
        __builtin_amdgcn_s_waitcnt(0);
        unsigned nloc = b.st[0], nx = b.st[1];
        if (nloc == 0u) { xcd_barrier_complete(bar, bx, nloc, nx); b.st[0] = nloc; b.st[1] = nx; }
        const unsigned old = xb_add(&bar[XB_XSUB(bx)], 1u);
        const unsigned gen = old / nloc;
        if (old + 1u == (gen + 1u) * nloc) {
            __builtin_amdgcn_fence(__ATOMIC_RELEASE, "agent");
            asm volatile("s_waitcnt vmcnt(0)" ::: "memory");
            const unsigned og = xb_add(&bar[XB_TOP], 1u);
            const unsigned tg = og / nx;
            if (og + 1u == (tg + 1u) * nx) xb_add(&bar[XB_TOPGEN], 1u);
            else XB_SPIN(xb_ld(&bar[XB_TOPGEN]) == tg, bar);
            __builtin_amdgcn_fence(__ATOMIC_ACQUIRE, "agent");
            xb_add(&bar[XB_XGEN(bx)], 1u);
            asm volatile("s_waitcnt vmcnt(0)" ::: "memory");
        } else {
            XB_SPIN(xb_ld(&bar[XB_XGEN(bx)]) == gen, bar);
            __builtin_amdgcn_fence(__ATOMIC_ACQUIRE, "agent");
            asm volatile("s_waitcnt vmcnt(0)" ::: "memory");
        }
    }
    __syncthreads();
}

__device__ __forceinline__ int pi64(int j) { return (j & 1) ? 32 + (j >> 1) : (j >> 1); }
__device__ __forceinline__ bool rope_tile(int t) { return (t >= 16 && t <= 20) || t == 22 || t == 24; }
__device__ __forceinline__ int win_src(int j) {
    const int t = j >> 8;
    if (t < 16) return j;
    if (t < 26) return rope_tile(t) ? ((j & ~63) + pi64(j & 63)) : j;
    if (t < 34) return j + 48;
    const int r = j - 8704; return r < 48 ? 6656 + r : -1;
}
struct SrcWin { const float* w; __device__ __forceinline__ float operator()(int k, int j) const { const int s = win_src(j); return s >= 0 ? w[(size_t)k * NSRC + s] : 0.f; } };
struct SrcPlain { const float* w; int n; __device__ __forceinline__ float operator()(int k, int j) const { return w[(size_t)k * n + j]; } };
struct SrcGU { const float* wg; const float* wu; __device__ __forceinline__ float operator()(int k, int j) const { const int t = j >> 8, r = j & 255; return r < 128 ? wg[(size_t)k * DFF + 128 * t + r] : wu[(size_t)k * DFF + 128 * t + r - 128]; } };
struct SrcCW1 { const float* wk; const float* wv; __device__ __forceinline__ float operator()(int k, int j) const { return j < 256 ? wk[(size_t)((k & ~63) + pi64(k & 63)) * 256 + j] : wv[(size_t)k * 256 + j - 256]; } };
struct SrcCW2 { const float* wk; const float* wv; __device__ __forceinline__ float operator()(int k, int j) const { return j < 64 ? wk[k * 64 + pi64(j)] : ((j >= 256 && j < 320) ? wv[k * 64 + j - 256] : 0.f); } };

template <class F>
__device__ __forceinline__ void tr_item(const F& f, bf16* WT, int K, int N, int item, LAS float* scr, int lane) {
    const int nblk = N / 32, kb = item / nblk, nb = item % nblk, k0 = 64 * kb, n0 = 32 * nb;
#pragma unroll 8
    for (int i = 0; i < 32; ++i) { const int kk = 2 * i + (lane >> 5); scr[kk * 33 + (lane & 31)] = f(k0 + kk, n0 + (lane & 31)); }
    LDS_WAIT(); asm volatile("" ::: "memory");
    const int c = lane & 7;
#pragma unroll
    for (int j = 0; j < 4; ++j) { const int n = (lane >> 3) + 8 * j; const LAS float* s = scr + (8 * c) * 33 + n;
        v4u o; o.x = pk2(s[0 * 33], s[1 * 33]); o.y = pk2(s[2 * 33], s[3 * 33]); o.z = pk2(s[4 * 33], s[5 * 33]); o.w = pk2(s[6 * 33], s[7 * 33]);
        *(v4u*)(WT + (size_t)(n0 + n) * K + k0 + 8 * c) = o; }
    LDS_WAIT(); asm volatile("" ::: "memory");
}

__device__ static const float ROPE_INVF[32] = {
    1.000000000e+00f, 7.498942614e-01f, 5.623413324e-01f, 4.216965139e-01f, 3.162277639e-01f, 2.371373773e-01f, 1.778279394e-01f, 1.333521307e-01f,
    1.000000015e-01f, 7.498941571e-02f, 5.623413250e-02f, 4.216965288e-02f, 3.162277490e-02f, 2.371373773e-02f, 1.778279431e-02f, 1.333521493e-02f,
    9.999999776e-03f, 7.498941850e-03f, 5.623413250e-03f, 4.216964822e-03f, 3.162277630e-03f, 2.371373586e-03f, 1.778279431e-03f, 1.333521446e-03f,
    1.000000047e-03f, 7.498942432e-04f, 5.623413017e-04f, 4.216965172e-04f, 3.162277571e-04f, 2.371373703e-04f, 1.778279402e-04f, 1.333521504e-04f };

__device__ __forceinline__ void sincos_acc(float ang, float& c, float& s) {
    const double a = (double)ang, twopi = 6.283185307179586476925287, inv2pi = 0.15915494309189533576888;
    const double k = __builtin_rint(a * inv2pi), r = a - k * twopi, r2 = r * r;
    double cs = 1.0, sn = 1.0, tc = 1.0, ts = 1.0;
#pragma unroll
    for (int n = 1; n <= 13; ++n) { tc = -tc * r2 / (double)((2 * n - 1) * (2 * n)); ts = -ts * r2 / (double)((2 * n) * (2 * n + 1)); cs += tc; sn += ts; }
    c = (float)cs; s = (float)(sn * r);
}

struct P0Args { const float* const* in; };
using pg8::Unit;
typedef const f32x4 (&AccRef)[2][2][4][2];

__device__ __forceinline__ v4u pack8(const float (&o)[8]) { v4u w; w.x = pk2(o[0], o[1]); w.y = pk2(o[2], o[3]); w.z = pk2(o[4], o[5]); w.w = pk2(o[6], o[7]); return w; }

struct EpiProj {
    static constexpr bool PERM = true, AFTER_DRAIN = false;
    int grp;
    __device__ __forceinline__ void operator()(AccRef acc, const Unit& u, int wr, int wc, int fr, int fq) const {
        const int pn = u.pn, rbase = u.pm * 256 + wr * 64 + fr;
        unsigned char* const ws = KWS();
        const float* const lb = (const float*)(ws + WS_VEC) + VEC_LB;
        const f32x2* const rope = (const f32x2*)(ws + WS_ROPE) + (size_t)grp * TG * 32;
#pragma unroll
        for (int ai = 0; ai < 2; ++ai)
#pragma unroll
            for (int m = 0; m < 4; ++m) {
                const int row = rbase + ai * 128 + m * 16;
                const int b = row >> 11, t = row & 2047;
#pragma unroll
                for (int bj = 0; bj < 2; ++bj) {
                    const int c0 = bj * 128 + wc * 32 + fq * 8;
                    float v[8];
#pragma unroll
                    for (int e = 0; e < 4; ++e) { v[e] = acc[ai][bj][m][0][e]; v[4 + e] = acc[ai][bj][m][1][e]; }
                    if (pn < 16) {
                        const int seg = pn >> 2, col = (pn & 3) * 256 + c0;
                        if (seg == 1) {
                            const f32x4 l0 = *(const f32x4*)(lb + col), l1 = *(const f32x4*)(lb + col + 4);
                            float o[8];
#pragma unroll
                            for (int e = 0; e < 8; ++e) { const float lbv = e < 4 ? l0[e] : l1[e - 4]; o[e] = flog(lbv + (1.0f - lbv) * sigm(v[e])); }
                            v4u w; w.x = pkh2(o[0], o[1]); w.y = pkh2(o[2], o[3]); w.z = pkh2(o[4], o[5]); w.w = pkh2(o[6], o[7]);
                            *(v4u*)(ws + (WS_HQ + (size_t)seg * (64 * MiB) + ((size_t)row * 1024 + col) * 2)) = w;
                        } else {
                            *(v4u*)(ws + (WS_HQ + (size_t)seg * (64 * MiB) + ((size_t)row * 1024 + col) * 2)) = pack8(v);
                        }
                    } else if (pn < 26) {
                        const bool rp = rope_tile(pn);
                        float o[8];
                        if (rp) {
                            const int i0 = (c0 & 63) >> 1;
                            const f32x4 cs0 = *(const f32x4*)(rope + (size_t)row * 32 + i0), cs1 = *(const f32x4*)(rope + (size_t)row * 32 + i0 + 2);
                            o[0] = v[0] * cs0[0] - v[1] * cs0[1]; o[1] = v[1] * cs0[0] + v[0] * cs0[1];
                            o[2] = v[2] * cs0[2] - v[3] * cs0[3]; o[3] = v[3] * cs0[2] + v[2] * cs0[3];
                            o[4] = v[4] * cs1[0] - v[5] * cs1[1]; o[5] = v[5] * cs1[0] + v[4] * cs1[1];
                            o[6] = v[6] * cs1[2] - v[7] * cs1[3]; o[7] = v[7] * cs1[2] + v[6] * cs1[3];
                        } else {
#pragma unroll
                            for (int e = 0; e < 8; ++e) o[e] = v[e];
                        }
                        const int hd = c0 >> 6, jh = c0 & 63;
                        if (pn < 20) {
                            const int head = (pn - 16) * 4 + hd;
#pragma unroll
                            for (int e = 0; e < 8; ++e) o[e] *= SM_C;
                            *(v4u*)((bf16*)(ws + WS_NQ) + ((size_t)(b * 16 + head) * S + t) * 64 + jh) = pack8(o);
                        } else if (pn == 23 || pn == 25) {
                            bf16* dst = (bf16*)(ws + (WS_KC + (size_t)(pn - 20) * (16 * MiB) + (((size_t)(b * 4 + hd) * 64 + jh) * S + t) * 2));
#pragma unroll
                            for (int e = 0; e < 8; ++e) dst[(size_t)e * S] = (bf16)(pk2(o[e], 0.f) & 0xffffu);
                        } else {
                            *(v4u*)(ws + (WS_KC + (size_t)(pn - 20) * (16 * MiB) + (((size_t)(b * 4 + hd) * S + t) * 64 + jh) * 2)) = pack8(o);
                        }
                    } else if (pn < 34) {
                        float o[8];
#pragma unroll
                        for (int e = 0; e < 8; ++e) o[e] = sigm(v[e]);
                        *(v4u*)(ws + (WS_GA + (size_t)((pn - 26) >> 2) * (64 * MiB) + ((size_t)row * 1024 + ((pn - 26) & 3) * 256 + c0) * 2)) = pack8(o);
                    } else {
                        if (c0 < 48) {
                            float* dst = (float*)(ws + WS_GATES) + (size_t)row * 48 + c0;
                            *(f32x4*)dst = (f32x4){sigm(v[0]), sigm(v[1]), sigm(v[2]), sigm(v[3])};
                            *(f32x4*)(dst + 4) = (f32x4){sigm(v[4]), sigm(v[5]), sigm(v[6]), sigm(v[7])};
                        }
                    }
                    asm volatile("" ::: "memory");
                }
            }
    }
};

struct EpiCmp1 {
    static constexpr bool PERM = true, AFTER_DRAIN = false;
    bf16* HC; const float* cb1;
    __device__ __forceinline__ void operator()(AccRef acc, const Unit& u, int wr, int wc, int fr, int fq) const {
        const int rbase = u.pm * 256 + wr * 64 + fr;
#pragma unroll
        for (int bj = 0; bj < 2; ++bj) {
            const int c0 = bj * 128 + wc * 32 + fq * 8;
            const f32x4 b0 = *(const f32x4*)(cb1 + u.pn * 256 + c0), b1 = *(const f32x4*)(cb1 + u.pn * 256 + c0 + 4);
#pragma unroll
            for (int ai = 0; ai < 2; ++ai)
#pragma unroll
                for (int m = 0; m < 4; ++m) {
                    const int row = rbase + ai * 128 + m * 16;
                    float o[8];
#pragma unroll
                    for (int e = 0; e < 4; ++e) { o[e] = siluf(acc[ai][bj][m][0][e] + b0[e]); o[4 + e] = siluf(acc[ai][bj][m][1][e] + b1[e]); }
                    *(v4u*)(HC + (size_t)row * 256 + c0) = pack8(o);
                }
        }
    }
};
struct EpiCmp2 {
    static constexpr bool PERM = true, AFTER_DRAIN = false;
    bf16* KCMP; bf16* VCMPT; const float* cb2;
    __device__ __forceinline__ void operator()(AccRef acc, const Unit& u, int wr, int wc, int fr, int fq) const {
        if (wc >= 2) return;
        const int c0 = wc * 32 + fq * 8, rbase = u.pm * 256 + wr * 64 + fr;
        const f32x4 b0 = *(const f32x4*)(cb2 + u.pn * 256 + c0), b1 = *(const f32x4*)(cb2 + u.pn * 256 + c0 + 4);
#pragma unroll
        for (int ai = 0; ai < 2; ++ai)
#pragma unroll
            for (int m = 0; m < 4; ++m) {
                const int row = rbase + ai * 128 + m * 16;
                float o[8];
#pragma unroll
                for (int e = 0; e < 4; ++e) { o[e] = acc[ai][0][m][0][e] + b0[e]; o[4 + e] = acc[ai][0][m][1][e] + b1[e]; }
                if (u.pn == 0) *(v4u*)(KCMP + (size_t)row * 64 + c0) = pack8(o);
                else { const int r2 = row - 8192, bh = r2 >> 7, n = r2 & 127; bf16* dst = VCMPT + ((size_t)bh * 64 + c0) * 128 + n;
#pragma unroll
                    for (int e = 0; e < 8; ++e) dst[e * 128] = (bf16)(pk2(o[e], 0.f) & 0xffffu); }
            }
    }
};
template <bool ACCUM> struct EpiMerge {
    static constexpr bool PERM = true, AFTER_DRAIN = false;
    __device__ __forceinline__ void operator()(AccRef acc, const Unit& u, int wr, int wc, int fr, int fq) const {
        const int rbase = u.pm * 256 + wr * 64 + fr;
        unsigned char* const ws = KWS();
        const bf16* const GT = (const bf16*)(ws + (ACCUM ? WS_GB : WS_GA)); bf16* const MG = (bf16*)(ws + WS_MERGED);
#pragma unroll
        for (int ai = 0; ai < 2; ++ai)
#pragma unroll
            for (int m = 0; m < 4; ++m) {
                const int row = rbase + ai * 128 + m * 16;
#pragma unroll
                for (int bj = 0; bj < 2; ++bj) {
                    const size_t off = (size_t)row * 1024 + u.pn * 256 + bj * 128 + wc * 32 + fq * 8;
                    const v4u gt = *(const v4u*)(GT + off);
                    float o[8];
                    o[0] = bflo(gt.x) * acc[ai][bj][m][0][0]; o[1] = bfhi(gt.x) * acc[ai][bj][m][0][1]; o[2] = bflo(gt.y) * acc[ai][bj][m][0][2]; o[3] = bfhi(gt.y) * acc[ai][bj][m][0][3];
                    o[4] = bflo(gt.z) * acc[ai][bj][m][1][0]; o[5] = bfhi(gt.z) * acc[ai][bj][m][1][1]; o[6] = bflo(gt.w) * acc[ai][bj][m][1][2]; o[7] = bfhi(gt.w) * acc[ai][bj][m][1][3];
                    if (ACCUM) { const v4u pv = *(const v4u*)(MG + off);
                        o[0] += bflo(pv.x); o[1] += bfhi(pv.x); o[2] += bflo(pv.y); o[3] += bfhi(pv.y); o[4] += bflo(pv.z); o[5] += bfhi(pv.z); o[6] += bflo(pv.w); o[7] += bfhi(pv.w); }
                    *(v4u*)(MG + off) = pack8(o);
                }
                asm volatile("" ::: "memory");
            }
    }
};
struct EpiResid {
    static constexpr bool PERM = false, AFTER_DRAIN = false;
    const float* res; float* out; float scale;
    __device__ __forceinline__ void operator()(AccRef acc, const Unit& u, int wr, int wc, int fr, int fq) const {
        const int rbase = u.pm * 256 + wr * 64 + fr;
#pragma unroll
        for (int ai = 0; ai < 2; ++ai)
#pragma unroll
            for (int m = 0; m < 4; ++m) {
                const int row = rbase + ai * 128 + m * 16;
#pragma unroll
                for (int bj = 0; bj < 2; ++bj)
#pragma unroll
                    for (int n = 0; n < 2; ++n) {
                        const size_t off = (size_t)row * 1024 + u.pn * 256 + bj * 128 + wc * 32 + n * 16 + fq * 4;
                        const f32x4 r = *(const f32x4*)(res + off);
                        *(f32x4*)(out + off) = r * DN_ALPHA + acc[ai][bj][m][n] * scale;
                    }
                asm volatile("" ::: "memory");
            }
    }
};
struct EpiGU {
    static constexpr bool PERM = true, AFTER_DRAIN = false;
    bf16* HID;
    __device__ __forceinline__ void operator()(AccRef acc, const Unit& u, int wr, int wc, int fr, int fq) const {
        const int rbase = u.pm * 256 + wr * 64 + fr;
#pragma unroll
        for (int ai = 0; ai < 2; ++ai)
#pragma unroll
            for (int m = 0; m < 4; ++m) {
                const int row = rbase + ai * 128 + m * 16;
                float o[8];
#pragma unroll
                for (int e = 0; e < 4; ++e) { o[e] = siluf(acc[ai][0][m][0][e]) * acc[ai][1][m][0][e]; o[4 + e] = siluf(acc[ai][0][m][1][e]) * acc[ai][1][m][1][e]; }
                *(v4u*)(HID + (size_t)row * DFF + u.pn * 128 + wc * 32 + fq * 8) = pack8(o);
            }
    }
};
struct OneUnit {
    int pm, pn; bool has;
    __device__ __forceinline__ bool next(int i, Unit& u) const { if (i == 0 && has) { u.pm = pm; u.pn = pn; return true; } return false; }
    __device__ __forceinline__ void a_ready(const Unit&) const {}
    __device__ __forceinline__ void done(const Unit&) const {}
};
__device__ __forceinline__ void hgrn_phase(LAS unsigned char* lds, const bf16* HQ, const bf16* HF, const bf16* HI, bf16* ORAW, int G, int c, int wv) {
    constexpr int CH = 32;
    LAS float* Fs = (LAS float*)lds;
    LAS float* Qs = (LAS float*)(lds + 16384);
    LAS float* Is = (LAS float*)(lds + 32768);
    LAS float* Os = (LAS float*)(lds + 40960);
    const int tid = fresh_tid(wv), lane = tid & 63, wave = tid >> 6, kg = lane & 15, vs = lane >> 4;
    const int stok = tid >> 4, sc8 = tid & 15;
    for (int unit = c; unit < BG * 16; unit += G) {
        const int vh = unit & 1, h = (unit >> 1) & 7, b = unit >> 4;
        const size_t row0 = (size_t)b * S;
        const int colq = h * 128, coli = h * 128 + vh * 64;
#if DBG_EXP == 1 || DBG_EXP == 2
        if (vh == (DBG_EXP == 1 ? 1 : 0)) {
            for (int r = tid; r < S * 8; r += 512) *(v4u*)(ORAW + (row0 + (r >> 3)) * 1024 + coli + (r & 7) * 8) = (v4u){0u, 0u, 0u, 0u};
            continue;
        }
#endif
        f32x2 st[8];
#pragma unroll
        for (int k = 0; k < 8; ++k) st[k] = (f32x2){0.f, 0.f};
        v4u rq, rf, ri;
        rq = *(const v4u*)(HQ + (row0 + stok) * 1024 + colq + sc8 * 8);
        rf = *(const v4u*)(HF + (row0 + stok) * 1024 + colq + sc8 * 8);
        ri = (v4u){0u, 0u, 0u, 0u};
        if (tid < 256) ri = *(const v4u*)(HI + (row0 + (tid >> 3)) * 1024 + coli + (tid & 7) * 8);
        for (int ch = 0; ch < S / CH; ++ch) {
            {
                LAS float* qd = Qs + stok * 128 + sc8 * 8; LAS float* fd = Fs + stok * 128 + sc8 * 8;
                *(LAS f32x4*)qd = (f32x4){bflo(rq.x), bfhi(rq.x), bflo(rq.y), bfhi(rq.y)};
                *(LAS f32x4*)(qd + 4) = (f32x4){bflo(rq.z), bfhi(rq.z), bflo(rq.w), bfhi(rq.w)};
                *(LAS f32x4*)fd = (f32x4){fexp(h2f_lo(rf.x)), fexp(h2f_hi(rf.x)), fexp(h2f_lo(rf.y)), fexp(h2f_hi(rf.y))};
                *(LAS f32x4*)(fd + 4) = (f32x4){fexp(h2f_lo(rf.z)), fexp(h2f_hi(rf.z)), fexp(h2f_lo(rf.w)), fexp(h2f_hi(rf.w))};
                if (tid < 256) { LAS float* id = Is + (tid >> 3) * 64 + (tid & 7) * 8;
                    *(LAS f32x4*)id = (f32x4){bflo(ri.x), bfhi(ri.x), bflo(ri.y), bfhi(ri.y)};
                    *(LAS f32x4*)(id + 4) = (f32x4){bflo(ri.z), bfhi(ri.z), bflo(ri.w), bfhi(ri.w)}; }
            }
            __syncthreads();
            if (ch + 1 < S / CH) {
                const size_t r1 = row0 + (size_t)(ch + 1) * CH;
                rq = *(const v4u*)(HQ + (r1 + stok) * 1024 + colq + sc8 * 8);
                rf = *(const v4u*)(HF + (r1 + stok) * 1024 + colq + sc8 * 8);
                if (tid < 256) ri = *(const v4u*)(HI + (r1 + (tid >> 3)) * 1024 + coli + (tid & 7) * 8);
            }
#pragma unroll 4
            for (int tt = 0; tt < CH; ++tt) {
                const f32x4 fa = *(const LAS f32x4*)(Fs + tt * 128 + kg * 8), fb = *(const LAS f32x4*)(Fs + tt * 128 + kg * 8 + 4);
                const f32x4 qa = *(const LAS f32x4*)(Qs + tt * 128 + kg * 8), qb = *(const LAS f32x4*)(Qs + tt * 128 + kg * 8 + 4);
                const f32x2 iv = *(const LAS f32x2*)(Is + tt * 64 + wave * 8 + vs * 2);
                f32x2 o = (f32x2){0.f, 0.f};
#pragma unroll
                for (int k = 0; k < 8; ++k) {
                    const float fk = k < 4 ? fa[k & 3] : fb[k & 3], qk = k < 4 ? qa[k & 3] : qb[k & 3];
                    st[k] = iv + (st[k] - iv) * fk;
                    o += st[k] * qk;
                }
                o.x = sum16(o.x); o.y = sum16(o.y);
                if (kg == 0) *(LAS f32x2*)(Os + tt * 64 + wave * 8 + vs * 2) = o;
            }
            __syncthreads();
            {
                const f32x4 ov = *(const LAS f32x4*)(Os + stok * 64 + sc8 * 4);
                v2u w; w.x = pk2(ov[0], ov[1]); w.y = pk2(ov[2], ov[3]);
                *(v2u*)(ORAW + (row0 + (size_t)ch * CH + stok) * 1024 + coli + sc8 * 4) = w;
            }
        }
        __syncthreads();
    }
}

__device__ __forceinline__ void anorm_phase(const bf16* ORAW, const bf16* HG, const float* norm_g, bf16* AOUT, int G, int c, int wv) {
    const int tid = fresh_tid(wv), lane = tid & 63, gw = c * 8 + (tid >> 6), ngw = G * 8;
    const int e0 = (lane & 7) * 16, col = (lane >> 3) * 128 + e0;
    f32x4 ng[4];
#pragma unroll
    for (int i = 0; i < 4; ++i) ng[i] = *(const f32x4*)(norm_g + e0 + 4 * i);
    for (int row = gw; row < TG; row += ngw) {
        const v4u o0 = *(const v4u*)(ORAW + (size_t)row * 1024 + col), o1 = *(const v4u*)(ORAW + (size_t)row * 1024 + col + 8);
        const v4u g0 = *(const v4u*)(HG + (size_t)row * 1024 + col), g1 = *(const v4u*)(HG + (size_t)row * 1024 + col + 8);
        float o[16], gg[16];
        o[0] = bflo(o0.x); o[1] = bfhi(o0.x); o[2] = bflo(o0.y); o[3] = bfhi(o0.y); o[4] = bflo(o0.z); o[5] = bfhi(o0.z); o[6] = bflo(o0.w); o[7] = bfhi(o0.w);
        o[8] = bflo(o1.x); o[9] = bfhi(o1.x); o[10] = bflo(o1.y); o[11] = bfhi(o1.y); o[12] = bflo(o1.z); o[13] = bfhi(o1.z); o[14] = bflo(o1.w); o[15] = bfhi(o1.w);
        gg[0] = bflo(g0.x); gg[1] = bfhi(g0.x); gg[2] = bflo(g0.y); gg[3] = bfhi(g0.y); gg[4] = bflo(g0.z); gg[5] = bfhi(g0.z); gg[6] = bflo(g0.w); gg[7] = bfhi(g0.w);
        gg[8] = bflo(g1.x); gg[9] = bfhi(g1.x); gg[10] = bflo(g1.y); gg[11] = bfhi(g1.y); gg[12] = bflo(g1.z); gg[13] = bfhi(g1.z); gg[14] = bflo(g1.w); gg[15] = bfhi(g1.w);
        float ss = 0.f;
#pragma unroll
        for (int i = 0; i < 16; ++i) ss += o[i] * o[i];
        ss = sum8(ss);
        const float rs = frsq(ss * (1.0f / 128.0f) + RMS_EPS);
        float r[16];
#pragma unroll
        for (int i = 0; i < 16; ++i) r[i] = o[i] * rs * ng[i >> 2][i & 3] * siluf(gg[i]);
        v4u w0, w1;
        w0.x = pk2(r[0], r[1]); w0.y = pk2(r[2], r[3]); w0.z = pk2(r[4], r[5]); w0.w = pk2(r[6], r[7]);
        w1.x = pk2(r[8], r[9]); w1.y = pk2(r[10], r[11]); w1.z = pk2(r[12], r[13]); w1.w = pk2(r[14], r[15]);
        *(v4u*)(AOUT + (size_t)row * 1024 + col) = w0; *(v4u*)(AOUT + (size_t)row * 1024 + col + 8) = w1;
    }
}

__device__ __forceinline__ void ln_rows(const float* src, float* of, bf16* ob, const float* gam, const float* bet, int nrows, int G, int c, int wv, float oscale = 1.f) {
    const int tid = fresh_tid(wv), lane = tid & 63, gw = c * 8 + (tid >> 6), ngw = G * 8;
    f32x4 gv[4], bv[4];
#pragma unroll
    for (int j = 0; j < 4; ++j) { gv[j] = *(const f32x4*)(gam + 4 * lane + 256 * j); bv[j] = *(const f32x4*)(bet + 4 * lane + 256 * j); }
    for (int row = gw; row < nrows; row += ngw) {
        const f32x4* xr = (const f32x4*)(src + (size_t)row * 1024) + lane;
        f32x4 v[4]; float s = 0.f;
#pragma unroll
        for (int j = 0; j < 4; ++j) { v[j] = xr[64 * j]; s += (v[j].x + v[j].y) + (v[j].z + v[j].w); }
        const float mean = wave_sum(s) * (1.f / 1024.f); float s2 = 0.f;
#pragma unroll
        for (int j = 0; j < 4; ++j) { v[j] = v[j] - mean; s2 += (v[j].x * v[j].x + v[j].y * v[j].y) + (v[j].z * v[j].z + v[j].w * v[j].w); }
        const float rstd = frsq(wave_sum(s2) * (1.f / 1024.f) + LN_EPS);
#pragma unroll
        for (int j = 0; j < 4; ++j) {
            const f32x4 y = (v[j] * rstd * gv[j] + bv[j]) * oscale;
            if (of) *((f32x4*)(of + (size_t)row * 1024) + lane + 64 * j) = y;
            if (ob) { v2u w; w.x = pk2(y.x, y.y); w.y = pk2(y.z, y.w); *((v2u*)(ob + (size_t)row * 1024) + lane + 64 * j) = w; }
        }
    }
}

#define MFMA16(a, b, c) __builtin_amdgcn_mfma_f32_16x16x32_bf16((a), (b), (c), 0, 0, 0)

__device__ __forceinline__ void nsa_scores(const bf16* Kp, int kbase, int j, int fq, const bf16x8 (&qf)[2][2], f32x4 (&sc)[2][2][2]) {
    const bf16* kr = Kp + (size_t)(kbase + 8 * (j >> 2) + (j & 3)) * 64 + fq * 8;
#pragma unroll
    for (int kh = 0; kh < 2; ++kh)
#pragma unroll
        for (int kb = 0; kb < 2; ++kb) {
            const bf16x8 k0 = *(const bf16x8*)(kr + (size_t)(32 * kh + 4 * kb) * 64), k1 = *(const bf16x8*)(kr + (size_t)(32 * kh + 4 * kb) * 64 + 32);
#pragma unroll
            for (int rb = 0; rb < 2; ++rb) {
                f32x4 a = (f32x4){0.f, 0.f, 0.f, 0.f};
                a = MFMA16(k0, qf[rb][0], a); a = MFMA16(k1, qf[rb][1], a);
                sc[rb][kh][kb] = a;
            }
        }
}
__device__ __forceinline__ void nsa_pv(const bf16* Vt, int ldv, int kbase, int j, int fq, const bf16x8 (&pb)[2][2], f32x4 (&oacc)[2][4]) {
#pragma unroll
    for (int db = 0; db < 4; ++db)
#pragma unroll
        for (int kh = 0; kh < 2; ++kh) {
            const bf16x8 vf = *(const bf16x8*)(Vt + (size_t)(16 * db + j) * ldv + kbase + 32 * kh + 8 * fq);
#pragma unroll
            for (int rb = 0; rb < 2; ++rb) oacc[rb][db] = MFMA16(vf, pb[rb][kh], oacc[rb][db]);
        }
}
__device__ __forceinline__ bf16x8 pack_p(const f32x4& a, const f32x4& b) {
    v4u w; w.x = pk2(a[0], a[1]); w.y = pk2(a[2], a[3]); w.z = pk2(b[0], b[1]); w.w = pk2(b[2], b[3]); return __builtin_bit_cast(bf16x8, w);
}
__device__ __forceinline__ float fq_max(float v) { v = fmaxf(v, __shfl_xor(v, 16)); v = fmaxf(v, __shfl_xor(v, 32)); return v; }
__device__ __forceinline__ float fq_sum(float v) { v += __shfl_xor(v, 16); v += __shfl_xor(v, 32); return v; }

__device__ __forceinline__ void nsa_online(const bf16* Vt, int ldv, int kbase, int j, int fq, f32x4 (&sc)[2][2][2], const int (&lo)[2], const int (&hi)[2], float negb,
                                           float (&mrun)[2], float (&lrun)[2], f32x4 (&oacc)[2][4]) {
    bf16x8 pb[2][2];
#pragma unroll
    for (int rb = 0; rb < 2; ++rb) {
        float mx = negb;
#pragma unroll
        for (int kh = 0; kh < 2; ++kh)
#pragma unroll
            for (int kb = 0; kb < 2; ++kb)
#pragma unroll
                for (int r = 0; r < 4; ++r) { const int key = kbase + 32 * kh + 8 * fq + 4 * kb + r; const bool ok = key > lo[rb] && key <= hi[rb];
                    const float s = ok ? sc[rb][kh][kb][r] * SM_C : negb; sc[rb][kh][kb][r] = s; mx = fmaxf(mx, s); }
        mx = fq_max(mx);
        const float mnew = fmaxf(mrun[rb], mx), alpha = __builtin_amdgcn_exp2f(mrun[rb] - mnew);
        float ls = 0.f;
#pragma unroll
        for (int kh = 0; kh < 2; ++kh)
#pragma unroll
            for (int kb = 0; kb < 2; ++kb)
#pragma unroll
                for (int r = 0; r < 4; ++r) { const int key = kbase + 32 * kh + 8 * fq + 4 * kb + r; const bool ok = key > lo[rb] && key <= hi[rb];
                    const float p = ok ? __builtin_amdgcn_exp2f(sc[rb][kh][kb][r] - mnew) : 0.f; sc[rb][kh][kb][r] = p; ls += p; }
        ls = fq_sum(ls);
        lrun[rb] = lrun[rb] * alpha + ls; mrun[rb] = mnew;
#pragma unroll
        for (int db = 0; db < 4; ++db) oacc[rb][db] = oacc[rb][db] * alpha;
        pb[rb][0] = pack_p(sc[rb][0][0], sc[rb][0][1]); pb[rb][1] = pack_p(sc[rb][1][0], sc[rb][1][1]);
    }
    nsa_pv(Vt, ldv, kbase, j, fq, pb, oacc);
}


constexpr int NSA_PITCH = 72, NSA_TILE = 64 * NSA_PITCH * 2;
constexpr int NSA_KT = 0, NSA_VT = 2 * NSA_TILE, NSA_PS = 40960, NSA_SCS = 73728, NSA_PARK = 40960  , NSA_MSK = 110592, NSA_UM = 110848;
typedef const GAS v4u* gv4p;

__device__ __forceinline__ void nsa_scores_lds(const LAS bf16* KT, int j, int fq, const bf16x8 (&qf)[2][2], f32x4 (&sc)[2][2][2], const bool (&need)[2]) {
    const LAS bf16* kr = KT + (8 * (j >> 2) + (j & 3)) * NSA_PITCH + fq * 8;
#pragma unroll
    for (int kh = 0; kh < 2; ++kh)
#pragma unroll
        for (int kb = 0; kb < 2; ++kb) {
            const bf16x8 k0 = *(const LAS bf16x8*)(kr + (32 * kh + 4 * kb) * NSA_PITCH), k1 = *(const LAS bf16x8*)(kr + (32 * kh + 4 * kb) * NSA_PITCH + 32);
#pragma unroll
            for (int rb = 0; rb < 2; ++rb) if (need[rb]) {
                f32x4 a = (f32x4){0.f, 0.f, 0.f, 0.f};
                a = MFMA16(k0, qf[rb][0], a); a = MFMA16(k1, qf[rb][1], a);
                sc[rb][kh][kb] = a;
            }
            asm volatile("" ::: "memory");
        }
}
__device__ __forceinline__ void nsa_pv_lds(const LAS bf16* VT, int j, int fq, const bf16x8 (&pb)[2][2], f32x4 (&oacc)[2][4], const bool (&need)[2]) {
#pragma unroll
    for (int db = 0; db < 4; ++db)
#pragma unroll
        for (int kh = 0; kh < 2; ++kh) {
            const bf16x8 vf = *(const LAS bf16x8*)(VT + (16 * db + j) * NSA_PITCH + 32 * kh + 8 * fq);
#pragma unroll
            for (int rb = 0; rb < 2; ++rb) if (need[rb]) oacc[rb][db] = MFMA16(vf, pb[rb][kh], oacc[rb][db]);
            asm volatile("" ::: "memory");
        }
}
template <bool BOUNDS>
__device__ __forceinline__ void nsa_soft(f32x4 (&s)[2][2], int kbase, int fq, int lo, int hi, bool rowok, float negb, float& mrun, float& lrun, f32x4 (&oacc)[4], bf16x8 (&pb)[2]) {
    float mx = negb;
    const int lo2 = lo - kbase - 8 * fq, hi2 = hi - kbase - 8 * fq;
#pragma unroll
    for (int kh = 0; kh < 2; ++kh)
#pragma unroll
        for (int kb = 0; kb < 2; ++kb)
#pragma unroll
            for (int r = 0; r < 4; ++r) {
                if (BOUNDS) { const bool ok = (32 * kh + 4 * kb + r) > lo2 && (32 * kh + 4 * kb + r) <= hi2; s[kh][kb][r] = ok ? s[kh][kb][r] : negb; }
                mx = fmaxf(mx, s[kh][kb][r]);
            }
    if (!BOUNDS) mx = rowok ? mx : negb;
    mx = fq_max(mx);
    const float mnew = fmaxf(mrun, mx), alpha = __builtin_amdgcn_exp2f(mrun - mnew);
    const float msub = (BOUNDS || rowok) ? mnew : 1e30f;
    float ls = 0.f;
#pragma unroll
    for (int kh = 0; kh < 2; ++kh)
#pragma unroll
        for (int kb = 0; kb < 2; ++kb)
#pragma unroll
            for (int r = 0; r < 4; ++r) {
                float p = __builtin_amdgcn_exp2f(s[kh][kb][r] - msub);
                if (BOUNDS) p = (s[kh][kb][r] > -1e29f) ? p : 0.f;
                s[kh][kb][r] = p; ls += p;
            }
    ls = fq_sum(ls);
    lrun = lrun * alpha + ls; mrun = mnew;
#pragma unroll
    for (int db = 0; db < 4; ++db) oacc[db] = oacc[db] * alpha;
    pb[0] = pack_p(s[0][0], s[0][1]); pb[1] = pack_p(s[1][0], s[1][1]);
}

__device__ __forceinline__ void nsa_phase(LAS unsigned char* lds, int G, int c, int wv, size_t bout_off = WS_BOUT) {
    const int tid = fresh_tid(wv), lane = tid & 63, wave = __builtin_amdgcn_readfirstlane(tid >> 6), j = lane & 15, fq = lane >> 4, qq = j >> 2, g = j & 3;
    LAS float* ps = (LAS float*)(lds + NSA_PS + wave * 4096);
    LAS float* scs = (LAS float*)(lds + NSA_SCS + wave * 1024);
    LAS unsigned* msk = (LAS unsigned*)(lds + NSA_MSK + wave * 32);
    LAS unsigned* um = (LAS unsigned*)(lds + NSA_UM);
    LAS f32x4* park = (LAS f32x4*)(lds + NSA_PARK + wave * 8192) + lane;
    const int trow = tid >> 3, tch = (tid & 7) * 8;
    LAS bf16* const ldsb = (LAS bf16*)lds;
    const int st_off = trow * NSA_PITCH + tch;
    float negb = NEG_BIG; asm volatile("" : "+v"(negb));
    constexpr int NUNITS = BG * 4 * 32;
#define NSA_UNIT(idx_, bh_, qb_) const int bh_ = (idx_) >> 5, qb_ = (((idx_) & 31) + 4 * ((idx_) >> 8)) & 31
    v4u rK0, rV0;
    rK0 = (v4u){0u, 0u, 0u, 0u}; rV0 = rK0;
    if (c < NUNITS) {
        NSA_UNIT(c, bh0, qb0); (void)qb0;
        unsigned char* const ws = KWS();
        const bf16* Kc = (const bf16*)(ws + WS_KCMP) + (size_t)bh0 * 128 * 64; const bf16* Vc = (const bf16*)(ws + WS_VCMPT) + (size_t)bh0 * 64 * 128;
        rK0 = *(gv4p)(Kc + trow * 64 + tch); rV0 = *(gv4p)(Vc + trow * 128 + tch);
    }
    for (int it = 0;; ++it) {
        const int idx = it * G + c; if (idx >= NUNITS) break;
        NSA_UNIT(idx, bh, qblk);
        const int b = bh >> 2, kvh = bh & 3, t0 = qblk * 64, cur = qblk;
        unsigned char* const ws = KWS();
        int tq[2]; tq[0] = t0 + 8 * wave + qq; tq[1] = tq[0] + 4;
        const bool two = (t0 + 63) >= 1055;
        if (two) {
            const bf16* Kc = (const bf16*)(ws + WS_KCMP) + (size_t)bh * 128 * 64; const bf16* Vc = (const bf16*)(ws + WS_VCMPT) + (size_t)bh * 64 * 128;
            const v4u rK1 = *(gv4p)(Kc + (64 + trow) * 64 + tch), rV1 = *(gv4p)(Vc + trow * 128 + 64 + tch);
            *(LAS v4u*)(ldsb + (NSA_KT + NSA_TILE) / 2 + st_off) = rK1; *(LAS v4u*)(ldsb + (NSA_VT + NSA_TILE) / 2 + st_off) = rV1;
        }
        *(LAS v4u*)(ldsb + NSA_KT / 2 + st_off) = rK0; *(LAS v4u*)(ldsb + NSA_VT / 2 + st_off) = rV0;
        __syncthreads();
        const int wlo = cur > 8 ? cur - 8 : 0;
        const bf16* Kw = (const bf16*)(ws + WS_KW) + (size_t)bh * S * 64; const bf16* Vw = (const bf16*)(ws + WS_VWT) + (size_t)bh * 64 * S;
        const bf16* Ks = (const bf16*)(ws + WS_KS) + (size_t)bh * S * 64; const bf16* Vs = (const bf16*)(ws + WS_VST) + (size_t)bh * 64 * S;
        rK0 = *(gv4p)(Kw + (size_t)(64 * wlo + trow) * 64 + tch); rV0 = *(gv4p)(Vw + (size_t)trow * S + 64 * wlo + tch);
        bf16x8 qf[2][2];
#pragma unroll
        for (int rb = 0; rb < 2; ++rb)
#pragma unroll
            for (int dh = 0; dh < 2; ++dh) qf[rb][dh] = __builtin_bit_cast(bf16x8, *(gv4p)((const bf16*)(ws + WS_NQ) + ((size_t)(b * 16 + kvh * 4 + g) * S + tq[rb]) * 64 + dh * 32 + fq * 8));
        f32x4 outv[2][4];
        const bool both[2] = {true, true};
        {
            int nmax[2];
#pragma unroll
            for (int rb = 0; rb < 2; ++rb) nmax[rb] = tq[rb] >= 31 ? ((tq[rb] - 31) >> 4) : -1;
            f32x4 s0[2][2][2], s1[2][2][2];
            nsa_scores_lds(ldsb + NSA_KT / 2, j, fq, qf, s0, both);
            if (two) nsa_scores_lds(ldsb + (NSA_KT + NSA_TILE) / 2, j, fq, qf, s1, both);
            else {
#pragma unroll
                for (int rb = 0; rb < 2; ++rb)
#pragma unroll
                    for (int kh = 0; kh < 2; ++kh)
#pragma unroll
                        for (int kb = 0; kb < 2; ++kb) s1[rb][kh][kb] = (f32x4){0.f, 0.f, 0.f, 0.f};
            }
            bf16x8 pb0[2][2], pb1[2][2];
#pragma unroll
            for (int rb = 0; rb < 2; ++rb) {
                float mx = negb;
                const int nm0 = nmax[rb] - 8 * fq, nm1 = nm0 - 64;
#pragma unroll
                for (int kh = 0; kh < 2; ++kh)
#pragma unroll
                    for (int kb = 0; kb < 2; ++kb)
#pragma unroll
                        for (int r = 0; r < 4; ++r) {
                            const float a = ((32 * kh + 4 * kb + r) <= nm0) ? s0[rb][kh][kb][r] : negb; s0[rb][kh][kb][r] = a; mx = fmaxf(mx, a);
                            const float bb = ((32 * kh + 4 * kb + r) <= nm1) ? s1[rb][kh][kb][r] : negb; s1[rb][kh][kb][r] = bb; mx = fmaxf(mx, bb);
                        }
                mx = fq_max(mx);
                float ls = 0.f;
#pragma unroll
                for (int kh = 0; kh < 2; ++kh)
#pragma unroll
                    for (int kb = 0; kb < 2; ++kb)
#pragma unroll
                        for (int r = 0; r < 4; ++r) {
                            const float a = ((32 * kh + 4 * kb + r) <= nm0) ? __builtin_amdgcn_exp2f(s0[rb][kh][kb][r] - mx) : 0.f; s0[rb][kh][kb][r] = a; ls += a;
                            const float bb = ((32 * kh + 4 * kb + r) <= nm1) ? __builtin_amdgcn_exp2f(s1[rb][kh][kb][r] - mx) : 0.f; s1[rb][kh][kb][r] = bb; ls += bb;
                        }
                ls = fq_sum(ls);
                const float inv = frcp(fmaxf(ls, 1e-30f));
#pragma unroll
                for (int kh = 0; kh < 2; ++kh) {
#pragma unroll
                    for (int kb = 0; kb < 2; ++kb) { s0[rb][kh][kb] = s0[rb][kh][kb] * inv; s1[rb][kh][kb] = s1[rb][kh][kb] * inv; }
                    pb0[rb][kh] = pack_p(s0[rb][kh][0], s0[rb][kh][1]); pb1[rb][kh] = pack_p(s1[rb][kh][0], s1[rb][kh][1]);
                    f32x4 a0, a1, b0, b1;
#pragma unroll
                    for (int r = 0; r < 4; ++r) { a0[r] = sum4(s0[rb][kh][0][r]); a1[r] = sum4(s0[rb][kh][1][r]); b0[r] = sum4(s1[rb][kh][0][r]); b1[r] = sum4(s1[rb][kh][1][r]); }
                    if (g == 0) {
                        LAS float* d = ps + (rb * 4 + qq) * 128 + 32 * kh + 8 * fq;
                        *(LAS f32x4*)d = a0; *(LAS f32x4*)(d + 4) = a1; *(LAS f32x4*)(d + 64) = b0; *(LAS f32x4*)(d + 68) = b1;
                    }
                }
            }
            f32x4 oc[2][4];
#pragma unroll
            for (int rb = 0; rb < 2; ++rb)
#pragma unroll
                for (int db = 0; db < 4; ++db) oc[rb][db] = (f32x4){0.f, 0.f, 0.f, 0.f};
            nsa_pv_lds(ldsb + NSA_VT / 2, j, fq, pb0, oc, both);
            if (two) nsa_pv_lds(ldsb + (NSA_VT + NSA_TILE) / 2, j, fq, pb1, oc, both);
#pragma unroll
            for (int rb = 0; rb < 2; ++rb) {
                const float gt = *(const GAS float*)((const float*)(ws + WS_GATES) + ((size_t)b * S + tq[rb]) * 48 + 0 * 16 + kvh * 4 + g);
#pragma unroll
                for (int db = 0; db < 4; ++db) outv[rb][db] = oc[rb][db] * gt;
            }
        }
        LDS_WAIT();
#pragma unroll 1
        for (int pass = 0; pass < 4; ++pass) {
            const int q8 = 2 * pass + (lane >> 5), k = lane & 31;
            const LAS float* pr = ps + q8 * 128;
            float imp = pr[4 * k] + pr[4 * k + 1] + pr[4 * k + 2] + 0.5f * pr[4 * k + 3];
            if (k > 0) imp += 0.5f * pr[4 * k - 1];
            const bool forced = (k == 0) || (k == cur) || (k == cur - 1);
            scs[q8 * 32 + k] = (k <= cur) ? imp + (forced ? 1000.0f : 0.0f) : -1.0f;
        }
        LDS_WAIT();
        unsigned wor = 0u;
#pragma unroll 1
        for (int pass = 0; pass < 4; ++pass) {
            const int q8 = 2 * pass + (lane >> 5), k = lane & 31;
            const LAS float* sr = scs + q8 * 32;
            const float my = sr[k];
            int rank = 0;
#pragma unroll
            for (int k2 = 0; k2 < 32; ++k2) { const float o = sr[k2]; rank += (o > my || (o == my && k2 < k)) ? 1 : 0; }
            const bool sel = (rank < 8) && (k <= cur);
            const unsigned long long bal = __ballot(sel);
            wor |= (unsigned)bal | (unsigned)(bal >> 32);
            if (lane == 0) { msk[2 * pass] = (unsigned)bal; msk[2 * pass + 1] = (unsigned)(bal >> 32); }
        }
        if (lane == 0) um[wave] = wor;
        LDS_WAIT();
        unsigned mym[2]; mym[0] = msk[qq]; mym[1] = msk[4 + qq];
        __syncthreads();
        *(LAS v4u*)(ldsb + NSA_KT / 2 + st_off) = rK0; *(LAS v4u*)(ldsb + NSA_VT / 2 + st_off) = rV0;
        unsigned uni = 0u;
#pragma unroll
        for (int w = 0; w < 8; ++w) uni |= um[w];
        uni = __builtin_amdgcn_readfirstlane(uni) | 1u;
#pragma unroll
        for (int rb = 0; rb < 2; ++rb)
#pragma unroll
            for (int db = 0; db < 4; ++db) park[(rb * 4 + db) * 64] = outv[rb][db];
        __syncthreads();
        float mrun[2] = {negb, negb}, lrun[2] = {0.f, 0.f};
        f32x4 oa[2][4];
#pragma unroll
        for (int rb = 0; rb < 2; ++rb)
#pragma unroll
            for (int db = 0; db < 4; ++db) oa[rb][db] = (f32x4){0.f, 0.f, 0.f, 0.f};
        int stage = 1, k = wlo, p = 0;
        for (;;) {
            int nstage = stage, nk = 0; bool has_next = true;
            if (stage == 1) { if (k < cur) nk = k + 1; else { nstage = 2; nk = 0; } }
            else { const unsigned rem = (k >= 31) ? 0u : (uni & ~((2u << k) - 1u)); if (rem) nk = __builtin_ctz(rem); else has_next = false; }
            if (has_next) {
                const bf16* Kn = nstage == 1 ? Kw : Ks; const bf16* Vn = nstage == 1 ? Vw : Vs;
                rK0 = *(gv4p)(Kn + (size_t)(64 * nk + trow) * 64 + tch); rV0 = *(gv4p)(Vn + (size_t)trow * S + 64 * nk + tch);
            } else {
                const int nidx = idx + G;
                if (nidx < NUNITS) { NSA_UNIT(nidx, nbh, nqb); (void)nqb;
                    const bf16* Kc = (const bf16*)(ws + WS_KCMP) + (size_t)nbh * 128 * 64; const bf16* Vc = (const bf16*)(ws + WS_VCMPT) + (size_t)nbh * 64 * 128;
                    rK0 = *(gv4p)(Kc + trow * 64 + tch); rV0 = *(gv4p)(Vc + trow * 128 + tch); }
            }
            const LAS bf16* KT = ldsb + (NSA_KT + p * NSA_TILE) / 2; const LAS bf16* VT = ldsb + (NSA_VT + p * NSA_TILE) / 2;
            bool rowok[2], need[2];
#pragma unroll
            for (int rb = 0; rb < 2; ++rb) { rowok[rb] = stage == 1 ? true : (((mym[rb] >> k) & 1u) != 0u); need[rb] = __ballot(rowok[rb]) != 0ull; }
            if (need[0] || need[1]) {
                f32x4 sc[2][2][2];
                nsa_scores_lds(KT, j, fq, qf, sc, need);
                bf16x8 pb[2][2];
                const bool bounds = (k == cur) || (stage == 1 && k + 8 == cur);
                if (bounds) {
#pragma unroll
                    for (int rb = 0; rb < 2; ++rb) if (need[rb]) {
                        const int lo = stage == 1 ? tq[rb] - 512 : -1, hi = rowok[rb] ? tq[rb] : -1;
                        nsa_soft<true>(sc[rb], 64 * k, fq, lo, hi, true, negb, mrun[rb], lrun[rb], oa[rb], pb[rb]);
                    }
                } else {
#pragma unroll
                    for (int rb = 0; rb < 2; ++rb) if (need[rb]) nsa_soft<false>(sc[rb], 64 * k, fq, 0, 0, rowok[rb], negb, mrun[rb], lrun[rb], oa[rb], pb[rb]);
                }
                nsa_pv_lds(VT, j, fq, pb, oa, need);
            }
            if (stage == 1 && k == cur) {
#pragma unroll
                for (int rb = 0; rb < 2; ++rb) {
                    const float gt = *(const GAS float*)((const float*)(ws + WS_GATES) + ((size_t)b * S + tq[rb]) * 48 + 2 * 16 + kvh * 4 + g) * frcp(fmaxf(lrun[rb], 1e-30f));
#pragma unroll
                    for (int db = 0; db < 4; ++db) { park[(rb * 4 + db) * 64] = park[(rb * 4 + db) * 64] + oa[rb][db] * gt; oa[rb][db] = (f32x4){0.f, 0.f, 0.f, 0.f}; }
                    mrun[rb] = negb; lrun[rb] = 0.f;
                }
            }
            if (has_next) { *(LAS v4u*)(ldsb + (NSA_KT + (p ^ 1) * NSA_TILE) / 2 + st_off) = rK0; *(LAS v4u*)(ldsb + (NSA_VT + (p ^ 1) * NSA_TILE) / 2 + st_off) = rV0; }
            __syncthreads();
            if (!has_next) break;
            p ^= 1; stage = nstage; k = nk;
        }
#pragma unroll
        for (int rb = 0; rb < 2; ++rb) {
            const float gt = *(const GAS float*)((const float*)(ws + WS_GATES) + ((size_t)b * S + tq[rb]) * 48 + 1 * 16 + kvh * 4 + g) * frcp(fmaxf(lrun[rb], 1e-30f));
            bf16* dst = (bf16*)(ws + bout_off) + ((size_t)b * S + tq[rb]) * 1024 + (kvh * 4 + g) * 64 + 4 * fq;
#pragma unroll
            for (int db = 0; db < 4; ++db) { f32x4 o = park[(rb * 4 + db) * 64] + oa[rb][db] * gt;
#if DBG_EXP == 3
                o = o * 0.f;
#endif
                v2u w; w.x = pk2(o[0], o[1]); w.y = pk2(o[2], o[3]); *(GAS v2u*)(dst + 16 * db) = w; }
        }
    }
#undef NSA_UNIT
}
#if DBG_CHK
__device__ __forceinline__ float bfr(float v) { return bflo(pk2(v, 0.f) & 0xffffu); }
__device__ __forceinline__ void dbg_flag(unsigned bit) { atomicOr((unsigned*)(KWS() + WS_CTL) + 8, bit); }
__device__ __forceinline__ bool dbg_bad(float got, float want) { return !(fabsf(got - want) <= 0.02f * fabsf(want) + 0.02f); }
__device__ __forceinline__ void dbg_check_proj(int G, int c, int wv) {
    const int tid = fresh_tid(wv), lane = tid & 63, gw = c * 8 + (tid >> 6), ngw = G * 8;
    unsigned char* ws = KWS(); const float* x = KIN(0); const float* win = KIN(2); const float* lb = (const float*)(ws + WS_VEC) + VEC_LB;
    for (int s = gw; s < 4096; s += ngw) {
        const int row = (s * 97) % TG, sel = s % 5, col = (s * 131) % 1024;
        const int src = sel < 4 ? sel * 1024 + col : 6704 + col;
        float acc = 0.f;
        for (int k = lane; k < 1024; k += 64) acc += bfr(x[(size_t)row * 1024 + k]) * bfr(win[(size_t)k * NSRC + src]);
        acc = wave_sum(acc);
        float got, want; unsigned bit;
        if (sel == 1) { const unsigned short h = ((const unsigned short*)(ws + WS_HF))[(size_t)row * 1024 + col]; got = (float)__builtin_bit_cast(_Float16, h); want = logf(lb[col] + (1.f - lb[col]) / (1.f + expf(-acc))); bit = 8u; }
        else if (sel == 4) { got = bflo(((const unsigned short*)(ws + WS_GA))[(size_t)row * 1024 + col]); want = 1.f / (1.f + expf(-acc)); bit = 8u; }
        else { const size_t base = sel == 0 ? WS_HQ : (sel == 2 ? WS_HI : WS_HG); got = bflo(((const unsigned short*)(ws + base))[(size_t)row * 1024 + col]); want = acc; bit = 4u; }
        if (lane == 0 && dbg_bad(got, want)) dbg_flag(bit);
    }
}
__device__ __forceinline__ void dbg_check_hgrn(int G, int c, int wv) {
    const int tid = fresh_tid(wv), lane = tid & 63, gw = c * 8 + (tid >> 6), ngw = G * 8;
    unsigned char* ws = KWS(); const bf16* HQ = (const bf16*)(ws + WS_HQ); const unsigned short* HF = (const unsigned short*)(ws + WS_HF); const bf16* HI = (const bf16*)(ws + WS_HI); const bf16* OR = (const bf16*)(ws + WS_ORAW);
    for (int s = gw; s < 256; s += ngw) {
        const int b = s & 15, h = (s >> 4) & 7, v = (s * 37 + 5) & 127;
        float s0 = 0.f, s1 = 0.f; int nbad = 0;
        for (int t = 0; t < S; ++t) {
            const size_t r = ((size_t)b * S + t) * 1024 + h * 128;
            const float f0 = expf((float)__builtin_bit_cast(_Float16, HF[r + lane])), f1 = expf((float)__builtin_bit_cast(_Float16, HF[r + lane + 64]));
            const float q0 = bflo(HQ[r + lane]), q1 = bflo(HQ[r + lane + 64]), iv = bflo(HI[r + v]);
            s0 = f0 * s0 + (1.f - f0) * iv; s1 = f1 * s1 + (1.f - f1) * iv;
            const float o = wave_sum(q0 * s0 + q1 * s1);
            if (dbg_bad(bflo(OR[r + v]), o)) ++nbad;
        }
        if (lane == 0 && nbad > 0) dbg_flag(1u);
    }
}
__device__ __forceinline__ void dbg_check_anorm(int G, int c, int wv) {
    const int tid = fresh_tid(wv), lane = tid & 63, gw = c * 8 + (tid >> 6), ngw = G * 8;
    unsigned char* ws = KWS(); const bf16* OR = (const bf16*)(ws + WS_ORAW); const bf16* HG = (const bf16*)(ws + WS_HG); const bf16* AO = (const bf16*)(ws + WS_AOUT); const float* ng = KIN(4);
    for (int s = gw; s < 2048; s += ngw) {
        const int row = (s * 61) % TG, h = s & 7; const size_t r = (size_t)row * 1024 + h * 128;
        const float o0 = bflo(OR[r + lane]), o1 = bflo(OR[r + lane + 64]);
        const float ss = wave_sum(o0 * o0 + o1 * o1), rs = 1.f / sqrtf(ss / 128.f + RMS_EPS);
        const float g0 = bflo(HG[r + lane]), g1 = bflo(HG[r + lane + 64]);
        const float w0 = o0 * rs * ng[lane] * g0 / (1.f + expf(-g0)), w1 = o1 * rs * ng[lane + 64] * g1 / (1.f + expf(-g1));
        const bool bad = dbg_bad(bflo(AO[r + lane]), w0) || dbg_bad(bflo(AO[r + lane + 64]), w1);
        if (__ballot(bad) != 0ull && lane == 0) dbg_flag(2u);
    }
}
__device__ __forceinline__ void dbg_check_merge(int G, int c, int wv) {
    const int tid = fresh_tid(wv), lane = tid & 63, gw = c * 8 + (tid >> 6), ngw = G * 8;
    unsigned char* ws = KWS(); const bf16* AO = (const bf16*)(ws + WS_AOUT); const bf16* BO = (const bf16*)(ws + WS_BOUT); const bf16* GA = (const bf16*)(ws + WS_GA); const bf16* GB = (const bf16*)(ws + WS_GB); const bf16* MG = (const bf16*)(ws + WS_MERGED);
    const float* wa = KIN(15); const float* wb = KIN(16);
    for (int s = gw; s < 4096; s += ngw) {
        const int row = (s * 97) % TG, col = (s * 131) % 1024;
        float a = 0.f, b = 0.f;
        for (int k = lane; k < 1024; k += 64) { a += bflo(AO[(size_t)row * 1024 + k]) * bfr(wa[(size_t)k * 1024 + col]); b += bflo(BO[(size_t)row * 1024 + k]) * bfr(wb[(size_t)k * 1024 + col]); }
        a = wave_sum(a); b = wave_sum(b);
        const float want = bflo(GA[(size_t)row * 1024 + col]) * a + bflo(GB[(size_t)row * 1024 + col]) * b;
        if (lane == 0 && dbg_bad(bflo(MG[(size_t)row * 1024 + col]), want)) dbg_flag(DBG_CHK == 2 ? 1u : 0u);
    }
}
__device__ __forceinline__ void dbg_check_pre1(int G, int c, int wv) {
    const int tid = fresh_tid(wv), lane = tid & 63, gw = c * 8 + (tid >> 6), ngw = G * 8;
    unsigned char* ws = KWS(); const bf16* MG = (const bf16*)(ws + WS_MERGED); const float* P1 = (const float*)(ws + WS_PRE1); const float* wo = KIN(17); const float* x = KIN(0);
    for (int s = gw; s < 4096; s += ngw) {
        const int row = (s * 97) % TG, col = (s * 131) % 1024;
        float a = 0.f;
        for (int k = lane; k < 1024; k += 64) a += bflo(MG[(size_t)row * 1024 + k]) * bfr(wo[(size_t)k * 1024 + col]);
        a = wave_sum(a);
        const float want = DN_ALPHA * x[(size_t)row * 1024 + col] + a;
        if (lane == 0 && dbg_bad(P1[(size_t)row * 1024 + col], want)) dbg_flag(DBG_CHK == 2 ? 2u : 0u);
    }
}
#endif
#if DBG_CHK == 3
__device__ __forceinline__ int ipi64(int d) { return d < 32 ? 2 * d : 2 * (d - 32) + 1; }
__device__ __forceinline__ bool dbg_bad2(float got, float want, float rel, float ab) { return !(fabsf(got - want) <= rel * fabsf(want) + ab); }
__device__ __forceinline__ float wave_max(float v) {
#pragma unroll
    for (int o = 1; o < 64; o <<= 1) v = fmaxf(v, __shfl_xor(v, o));
    return v;
}
__device__ __forceinline__ void dbg_check_nsa(LAS unsigned char* lds, int G, int c, int wv) {
    const int tid = fresh_tid(wv), lane = tid & 63, gw = c * 8 + wv, ngw = G * 8;
    LAS float* Lq = (LAS float*)(lds + wv * 4096); LAS float* Lp = Lq + 256; LAS float* Ls = Lq + 768;
    unsigned char* ws = KWS();
    const bf16* NQ = (const bf16*)(ws + WS_NQ); const bf16* KS = (const bf16*)(ws + WS_KS); const bf16* VST = (const bf16*)(ws + WS_VST); const bf16* KW = (const bf16*)(ws + WS_KW); const bf16* VWT = (const bf16*)(ws + WS_VWT);
    const bf16* KCM = (const bf16*)(ws + WS_KCMP); const bf16* VCT = (const bf16*)(ws + WS_VCMPT); const float* GT = (const float*)(ws + WS_GATES); const bf16* BO = (const bf16*)(ws + WS_BOUT);
    for (int s = gw; s < 2048; s += ngw) {
        const int b = s & 15, kvh = (s >> 4) & 3;
        int t = (s * 613 + 17) & 2047; if (s < 64) t = s;
        const int bh = b * 4 + kvh, cur = t >> 6;
        _Pragma("unroll") for (int g = 0; g < 4; ++g) Lq[g * 64 + lane] = bflo(NQ[((size_t)(b * 16 + kvh * 4 + g) * S + t) * 64 + lane]);
        LDS_WAIT();
        float outv[4] = {0.f, 0.f, 0.f, 0.f};
        const int nmax = t >= 31 ? (t - 31) >> 4 : -1;
        float sc[4][2];
        _Pragma("unroll") for (int h2 = 0; h2 < 2; ++h2) { const int n = lane + 64 * h2;
            _Pragma("unroll") for (int g = 0; g < 4; ++g) { float a = 0.f; _Pragma("unroll 2") for (int d = 0; d < 64; ++d) a += Lq[g * 64 + d] * bflo(KCM[((size_t)bh * 128 + n) * 64 + d]); sc[g][h2] = n <= nmax ? a * 0.6931471805599453f : -1e30f; } }
        _Pragma("unroll") for (int g = 0; g < 4; ++g) {
            const float m = wave_max(fmaxf(sc[g][0], sc[g][1]));
            const float e0 = lane <= nmax ? expf(sc[g][0] - m) : 0.f, e1 = lane + 64 <= nmax ? expf(sc[g][1] - m) : 0.f;
            const float l = fmaxf(wave_sum(e0 + e1), 1e-30f);
            Lp[g * 128 + lane] = e0 / l; Lp[g * 128 + lane + 64] = e1 / l;
        }
        LDS_WAIT();
        _Pragma("unroll") for (int g = 0; g < 4; ++g) { float a = 0.f; _Pragma("unroll 2") for (int n = 0; n < 128; ++n) a += Lp[g * 128 + n] * bflo(VCT[((size_t)bh * 64 + lane) * 128 + n]);
            outv[g] = GT[((size_t)b * S + t) * 48 + 0 * 16 + kvh * 4 + g] * a; }
        if (lane < 32) { const int k = lane; float imp = 0.f;
            _Pragma("unroll") for (int g = 0; g < 4; ++g) { const LAS float* pr = Lp + g * 128; imp += pr[4 * k] + pr[4 * k + 1] + pr[4 * k + 2] + 0.5f * pr[4 * k + 3] + (k > 0 ? 0.5f * pr[4 * k - 1] : 0.f); }
            const bool forced = k == 0 || k == cur || k == cur - 1;
            Ls[k] = k <= cur ? imp + (forced ? 1000.f : 0.f) : -1.f; }
        LDS_WAIT();
        bool sel = false;
        if (lane < 32) { const float my = Ls[lane]; int rank = 0; _Pragma("unroll 2") for (int k2 = 0; k2 < 32; ++k2) { const float o = Ls[k2]; rank += (o > my || (o == my && k2 < lane)) ? 1 : 0; } sel = rank < 8 && lane <= cur; }
        const unsigned smask = (unsigned)__ballot(sel);
        LDS_WAIT();
        _Pragma("unroll 1") for (int br = 1; br < 3; ++br) {
            const bf16* Kp = (br == 1 ? KS : KW) + (size_t)bh * S * 64; const bf16* Vp = (br == 1 ? VST : VWT) + (size_t)bh * 64 * S;
            float m[4] = {-1e30f, -1e30f, -1e30f, -1e30f}, l[4] = {0.f, 0.f, 0.f, 0.f}, o[4] = {0.f, 0.f, 0.f, 0.f};
            const int k0 = br == 1 ? 0 : (cur > 8 ? cur - 8 : 0);
            _Pragma("unroll 1") for (int kb = k0; kb <= cur; ++kb) {
                if (br == 1 && !((smask >> kb) & 1u)) continue;
                const int key = 64 * kb + lane;
                const bool ok = key <= t && (br == 1 || key > t - 512);
                _Pragma("unroll") for (int g = 0; g < 4; ++g) {
                    float a = 0.f; _Pragma("unroll 2") for (int d = 0; d < 64; ++d) a += Lq[g * 64 + d] * bflo(Kp[(size_t)key * 64 + d]);
                    const float sv = ok ? a * 0.6931471805599453f : -1e30f;
                    const float mn = fmaxf(m[g], wave_max(sv)), al = expf(m[g] - mn), p = ok ? expf(sv - mn) : 0.f;
                    l[g] = l[g] * al + wave_sum(p); m[g] = mn; Lp[g * 128 + lane] = p; o[g] *= al;
                }
                LDS_WAIT();
                _Pragma("unroll") for (int g = 0; g < 4; ++g) { float a = 0.f; _Pragma("unroll 2") for (int j2 = 0; j2 < 64; ++j2) a += Lp[g * 128 + j2] * bflo(Vp[(size_t)lane * S + 64 * kb + j2]); o[g] += a; }
                LDS_WAIT();
            }
            _Pragma("unroll") for (int g = 0; g < 4; ++g) outv[g] += GT[((size_t)b * S + t) * 48 + br * 16 + kvh * 4 + g] * o[g] / fmaxf(l[g], 1e-30f);
        }
        bool bad = false;
        _Pragma("unroll") for (int g = 0; g < 4; ++g) bad |= dbg_bad2(bflo(BO[((size_t)b * S + t) * 1024 + (kvh * 4 + g) * 64 + lane]), outv[g], 0.04f, 0.006f);
        if (__ballot(bad) != 0ull && lane == 0) atomicAdd((unsigned*)(KWS() + WS_CTL) + 9, 1u);
        LDS_WAIT();
    }
}
__device__ __forceinline__ void dbg_check_cmp(LAS unsigned char* lds, int G, int c, int wv) {
    const int tid = fresh_tid(wv), lane = tid & 63, gw = c * 8 + wv, ngw = G * 8;
    LAS float* Lh = (LAS float*)(lds + 65536 + wv * 1024);
    unsigned char* ws = KWS();
    for (int s = gw; s < 256; s += ngw) {
        const int isv = s & 1, bh = (s >> 1) & 63, n = (s * 29 + 3) % 127;
        const bf16* X = (const bf16*)(ws + (isv ? WS_VC : WS_KC)) + (size_t)bh * S * 64;
        const float* pos = KIN(isv ? 10 : 5); const float* w1 = KIN(isv ? 11 : 6); const float* b1 = KIN(isv ? 12 : 7); const float* w2 = KIN(isv ? 13 : 8); const float* b2 = KIN(isv ? 14 : 9);
        float h[4] = {0.f, 0.f, 0.f, 0.f};
        for (int l = 0; l < 32; ++l) _Pragma("unroll 2") for (int d = 0; d < 64; ++d) {
            const float xv = bflo(X[(size_t)(16 * n + l) * 64 + (isv ? d : ipi64(d))]);
            _Pragma("unroll") for (int q = 0; q < 4; ++q) h[q] += xv * bfr(w1[(size_t)(l * 64 + d) * 256 + lane + 64 * q]) + pos[l * 64 + d] * w1[(size_t)(l * 64 + d) * 256 + lane + 64 * q];
        }
        _Pragma("unroll") for (int q = 0; q < 4; ++q) { const float z = h[q] + b1[lane + 64 * q]; Lh[lane + 64 * q] = bfr(z / (1.f + expf(-z))); }
        LDS_WAIT();
        float o = b2[lane];
        for (int j2 = 0; j2 < 256; ++j2) o += Lh[j2] * bfr(w2[j2 * 64 + lane]);
        const float got = isv ? bflo(((const bf16*)(ws + WS_VCMPT))[((size_t)bh * 64 + lane) * 128 + n]) : bflo(((const bf16*)(ws + WS_KCMP))[((size_t)bh * 128 + n) * 64 + ipi64(lane)]);
        if (__ballot(dbg_bad2(got, o, 0.03f, 0.02f)) != 0ull && lane == 0) dbg_flag(2u);
        LDS_WAIT();
    }
}
__device__ __forceinline__ void dbg_check_qkv(int G, int c, int wv) {
    const int tid = fresh_tid(wv), lane = tid & 63, gw = c * 8 + (tid >> 6), ngw = G * 8;
    unsigned char* ws = KWS(); const float* x = KIN(0); const float* win = KIN(2); const int* posi = (const int*)karg(1);
    for (int s = gw; s < 1024; s += ngw) {
        const int row = (s * 193 + 7) % TG, which = s % 7, b = row >> 11, t = row & 2047;
        const int head = which == 0 ? (s >> 3) & 15 : (s >> 3) & 3;
        const int src0 = which == 0 ? 4096 : 5120 + (which - 1) * 256;
        float a = 0.f;
        for (int k = 0; k < 1024; ++k) a += bfr(x[(size_t)row * 1024 + k]) * bfr(win[(size_t)k * NSRC + src0 + head * 64 + lane]);
        float want = a; bool isk = which == 0 || which == 1 || which == 3 || which == 5;
        if (isk) { const float partner = __shfl_xor(a, 32); const int i = lane & 31; const float ang = (float)posi[row] * powf(10000.f, -(float)i / 32.f);
            const float cs = cosf(ang), sn = sinf(ang); want = lane < 32 ? a * cs - partner * sn : a * cs + partner * sn; }
        float got; unsigned bit = isk ? 4u : 8u;
        if (which == 0) { got = bflo(((const bf16*)(ws + WS_NQ))[((size_t)(b * 16 + head) * S + t) * 64 + ipi64(lane)]); want *= SM_C; }
        else if (which == 4 || which == 6) got = bflo(((const bf16*)(ws + (which == 4 ? WS_VST : WS_VWT)))[((size_t)(b * 4 + head) * 64 + lane) * S + t]);
        else { const size_t base = which == 1 ? WS_KC : (which == 2 ? WS_VC : (which == 3 ? WS_KS : WS_KW)); got = bflo(((const bf16*)(ws + base))[((size_t)(b * 4 + head) * S + t) * 64 + (isk ? ipi64(lane) : lane)]); }
        if (__ballot(dbg_bad2(got, want, 0.02f, 0.02f)) != 0ull && lane == 0) dbg_flag(bit);
    }
}
#endif
#ifndef PH_P0
#define PH_P0 1
#endif
#ifndef PH_P1
#define PH_P1 1
#endif
#ifndef PH_CMP
#define PH_CMP 1
#endif
#ifndef PH_HG
#define PH_HG 1
#endif
#ifndef PH_AN
#define PH_AN 1
#endif
#ifndef PH_NSA
#define PH_NSA 1
#endif
#ifndef PH_P4
#define PH_P4 1
#endif
#ifndef PH_P5
#define PH_P5 1
#endif
#ifndef PH_LN
#define PH_LN 1
#endif
#ifndef PH_P7
#define PH_P7 1
#endif
#ifndef PH_P8
#define PH_P8 1
#endif
struct Args { const void* in[25]; float* out; unsigned char* ws; };

__global__ void __launch_bounds__(512, 2) nsa_hgrn_fwd(Args args) {
    extern __shared__ __attribute__((aligned(16))) unsigned char lds_raw[];
    LAS unsigned char* lds = (LAS unsigned char*)lds_raw;
    const int G = gridDim.x, c = blockIdx.x, wv = __builtin_amdgcn_readfirstlane(threadIdx.x >> 6);
    unsigned char* ws = KWS();
    for (int u = threadIdx.x; u < (LDS_BYTES - LDSCTL_OFF) / 4; u += 512) ((LAS unsigned*)(lds + LDSCTL_OFF))[u] = 0u;
    __syncthreads();
    XcdBarrier bar = xcd_barrier_post((unsigned*)(ws + WS_CTL) + CW_BAR, (volatile LAS unsigned*)(lds + MISC_OFF) + 8);


#if PH_P0
    {
        const int tid = fresh_tid(wv), lane = tid & 63, wave = __builtin_amdgcn_readfirstlane(tid >> 6), gw = c * 8 + wave, ngw = G * 8, gt = c * 512 + tid, ngt = G * 512;
        LAS float* scr = (LAS float*)(lds + wave * 16384);
        constexpr int I_WIN = 16 * (NPROJ / 32), I_SQ = 16 * 32, I_GU = 16 * (NGU / 32), I_D = (DFF / 64) * 32, I_C1 = 32 * 16, I_C2 = 4 * 16;
        constexpr int NITEMS = I_WIN + 3 * I_SQ + I_GU + I_D + I_C1 + I_C2;
        const SrcWin fwin{KIN(2)};
        const SrcPlain fa{KIN(15), 1024}, fb{KIN(16), 1024}, fo{KIN(17), 1024}, fd{KIN(22), 1024};
        const SrcGU fgu{KIN(20), KIN(21)};
        const SrcCW1 fc1{KIN(6), KIN(11)};
        const SrcCW2 fc2{KIN(8), KIN(13)};
        for (int it = gw; it < NITEMS; it += ngw) {
            int r = it;
            if (r < I_WIN) { tr_item(fwin, (bf16*)(KWS() + WS_WIN), 1024, NPROJ, r, scr, lane); continue; } r -= I_WIN;
            if (r < I_SQ) { tr_item(fa, (bf16*)(KWS() + WS_WA), 1024, 1024, r, scr, lane); continue; } r -= I_SQ;
            if (r < I_SQ) { tr_item(fb, (bf16*)(KWS() + WS_WB), 1024, 1024, r, scr, lane); continue; } r -= I_SQ;
            if (r < I_SQ) { tr_item(fo, (bf16*)(KWS() + WS_WO), 1024, 1024, r, scr, lane); continue; } r -= I_SQ;
            if (r < I_GU) { tr_item(fgu, (bf16*)(KWS() + WS_WGU), 1024, NGU, r, scr, lane); continue; } r -= I_GU;
            if (r < I_D) { tr_item(fd, (bf16*)(KWS() + WS_WD), DFF, 1024, r, scr, lane); continue; } r -= I_D;
            if (r < I_C1) { tr_item(fc1, (bf16*)(KWS() + WS_CW1), 2048, 512, r, scr, lane); continue; } r -= I_C1;
            tr_item(fc2, (bf16*)(KWS() + WS_CW2), 256, 512, r, scr, lane);
        }
        const float* lbl = KIN(3);
        for (int i = gt; i < 1024; i += ngt) ((float*)(KWS() + WS_VEC))[VEC_LB + i] = sigm(lbl[i] - lbl[1024 + i]);
        for (int o = gw; o < 512; o += ngw) {
            const bool isv = o >= 256; const int jj = o & 255;
            const float* pos = KIN(isv ? 10 : 5); const float* w1 = KIN(isv ? 11 : 6); const float* b1 = KIN(isv ? 12 : 7);
            float s = 0.f;
            for (int kk = lane; kk < 2048; kk += 64) s += pos[kk] * w1[(size_t)kk * 256 + jj];
            s = wave_sum(s);
            if (lane == 0) ((float*)(KWS() + WS_VEC))[VEC_CB1 + o] = s + b1[jj];
        }
        for (int i = gt; i < 512; i += ngt) {
            float v = 0.f;
            if (i < 64) v = (KIN(9))[pi64(i)]; else if (i >= 256 && i < 320) v = (KIN(14))[i - 256];
            ((float*)(KWS() + WS_VEC))[VEC_CB2 + i] = v;
        }
        for (int e = gt; e < BATCH * S * 32; e += ngt) {
            const float ang = (float)((const int*)karg(1))[e >> 5] * ROPE_INVF[e & 31];
            float cs, sn; sincos_acc(ang, cs, sn);
            ((f32x2*)(KWS() + WS_ROPE))[e] = (f32x2){cs, sn};
        }
    }

#endif
    for (int grp = 0; grp < NGRP; ++grp) {
        {
            const int gt = fresh_s(c) * 512 + fresh_tid(wv), ngt = fresh_s(G) * 512;
            bf16* XB = (bf16*)(KWS() + WS_XB); const float* xg = KIN(0) + (size_t)grp * TG * 1024;
            for (int i = gt; i < TG * 1024 / 8; i += ngt) {
                const f32x4 a = *(const f32x4*)(xg + (size_t)i * 8), b2 = *(const f32x4*)(xg + (size_t)i * 8 + 4);
                v4u w; w.x = pk2(a[0], a[1]); w.y = pk2(a[2], a[3]); w.z = pk2(b2[0], b2[1]); w.w = pk2(b2[2], b2[3]);
                *(v4u*)(XB + (size_t)i * 8) = w;
            }
        }
        xcd_barrier(bar);
#if PH_P1
        {
            pg8::Gemm g{(const bf16*)(KWS() + WS_XB), (const bf16*)(KWS() + WS_WIN), TG, NPROJ, 1024, 1024};
            pg8::StaticOrder So; So.init(TG, NPROJ, fresh_s(G), fresh_s(c));
            EpiProj E{grp};
            pg8::gemm_phase<EpiProj, pg8::StaticOrder, true, true>(lds, g, So, E, wv);
        }
#endif
        xcd_barrier(bar);
#if DBG_CHK == 1
        if (grp == 0) dbg_check_proj(fresh_s(G), fresh_s(c), wv);
#endif
#if DBG_CHK == 3
        if (grp == 0 && (DBG_SUB & 4)) dbg_check_qkv(fresh_s(G), fresh_s(c), wv);
#endif
#if PH_CMP
        if (fresh_s(c) < 64) {
            const int cc = fresh_s(c);
            {
                pg8::Gemm g{(const bf16*)(KWS() + WS_KC), (const bf16*)(KWS() + WS_CW1), 16384, 512, 2048, 1024};
                OneUnit So{cc, cc >> 5, true};
                EpiCmp1 E{(bf16*)(KWS() + WS_HC), (float*)(KWS() + WS_VEC) + VEC_CB1};
                pg8::gemm_phase<EpiCmp1, OneUnit, false, true>(lds, g, So, E, wv);
            }
            VM_WAIT(); __syncthreads();
            {
                pg8::Gemm g{(const bf16*)(KWS() + WS_HC), (const bf16*)(KWS() + WS_CW2), 16384, 512, 256, 256};
                OneUnit So{cc, cc >> 5, true};
                EpiCmp2 E{(bf16*)(KWS() + WS_KCMP), (bf16*)(KWS() + WS_VCMPT), (float*)(KWS() + WS_VEC) + VEC_CB2};
                pg8::gemm_phase<EpiCmp2, OneUnit, false, true>(lds, g, So, E, wv);
            }
            __syncthreads();
        }
#endif
#if PH_HG
        hgrn_phase(lds, (const bf16*)(KWS() + WS_HQ), (const bf16*)(KWS() + WS_HF), (const bf16*)(KWS() + WS_HI), (bf16*)(KWS() + WS_ORAW), fresh_s(G), fresh_s(c), wv);
#if DUP_HG
        __syncthreads(); hgrn_phase(lds, (const bf16*)(KWS() + WS_HQ), (const bf16*)(KWS() + WS_HF), (const bf16*)(KWS() + WS_HI), (bf16*)(KWS() + WS_ORAW), fresh_s(G), fresh_s(c), wv);
#endif
#endif
        xcd_barrier(bar);
#if DBG_CHK == 1
        if (grp == 0) dbg_check_hgrn(fresh_s(G), fresh_s(c), wv);
#endif
#if PH_AN
        anorm_phase((const bf16*)(KWS() + WS_ORAW), (const bf16*)(KWS() + WS_HG), KIN(4), (bf16*)(KWS() + WS_AOUT), fresh_s(G), fresh_s(c), wv);
#endif
#if PH_NSA
        {
            nsa_phase(lds, fresh_s(G), fresh_s(c), wv);
#if DUP_NSA
            __syncthreads(); nsa_phase(lds, fresh_s(G), fresh_s(c), wv);
#endif
        }
#endif
        xcd_barrier(bar);
#if DBG_CHK == 1
        if (grp == 0) dbg_check_anorm(fresh_s(G), fresh_s(c), wv);
#endif
#if DBG_CHK == 4
        {
            const int cc2 = fresh_s(c), GG2 = fresh_s(G);
            nsa_phase(lds, GG2, cc2, wv, (size_t)880 * MiB);
            xcd_barrier(bar);
            const int gt2 = cc2 * 512 + fresh_tid(wv), ngt2 = GG2 * 512; unsigned nb = 0;
            const v4u* p1 = (const v4u*)(KWS() + WS_BOUT); const v4u* p2 = (const v4u*)(KWS() + (size_t)880 * MiB);
            for (int i = gt2; i < TG * 1024 / 8; i += ngt2) { const v4u a = p1[i], b2 = p2[i]; nb += (a.x != b2.x || a.y != b2.y || a.z != b2.z || a.w != b2.w) ? 1u : 0u; }
            if (nb) atomicAdd((unsigned*)(KWS() + WS_CTL) + 9, nb);
        }
#endif
#if DBG_CHK == 3
        if (grp == 0) { if (DBG_SUB & 1) dbg_check_nsa(lds, fresh_s(G), fresh_s(c), wv); if (DBG_SUB & 2) dbg_check_cmp(lds, fresh_s(G), fresh_s(c), wv); }
        __syncthreads();
#endif
#if DBG_DELAY
        if ((fresh_s(c) % 3) == 0) { const unsigned long long t0 = __builtin_amdgcn_s_memrealtime(); while (__builtin_amdgcn_s_memrealtime() - t0 < (unsigned long long)DBG_DELAY * 100ull) __builtin_amdgcn_s_sleep(8); }
#endif
#if PH_P4
        {
            pg8::StaticOrder So; So.init(TG, 1024, fresh_s(G), fresh_s(c));
            {
                pg8::Gemm g{(const bf16*)(KWS() + WS_AOUT), (const bf16*)(KWS() + WS_WA), TG, 1024, 1024, 1024};
                EpiMerge<false> E{};
                pg8::gemm_phase<EpiMerge<false>, pg8::StaticOrder, true, true>(lds, g, So, E, wv);
            }
            VM_WAIT(); __syncthreads();
            {
                pg8::Gemm g{(const bf16*)(KWS() + WS_BOUT), (const bf16*)(KWS() + WS_WB), TG, 1024, 1024, 1024};
                EpiMerge<true> E{};
                pg8::gemm_phase<EpiMerge<true>, pg8::StaticOrder, true, true>(lds, g, So, E, wv);
            }
        }
#endif
        xcd_barrier(bar);
#if DBG_CHK == 2
        if (grp == 0) dbg_check_merge(fresh_s(G), fresh_s(c), wv);
#endif
#if PH_P5
        {
            pg8::Gemm g{(const bf16*)(KWS() + WS_MERGED), (const bf16*)(KWS() + WS_WO), TG, 1024, 1024, 1024};
            pg8::StaticOrder So; So.init(TG, 1024, fresh_s(G), fresh_s(c));
            EpiResid E{KIN(0) + (size_t)grp * TG * 1024, (float*)(KWS() + WS_PRE1), DBG_EXP == 5 ? 0.f : 1.f};
            pg8::gemm_phase<EpiResid, pg8::StaticOrder, true, true>(lds, g, So, E, wv);
        }
#endif
        xcd_barrier(bar);
#if DBG_CHK == 2
        if (grp == 0) dbg_check_pre1(fresh_s(G), fresh_s(c), wv);
#endif
#if PH_LN
        ln_rows((const float*)(KWS() + WS_PRE1), (float*)(KWS() + WS_PRE1), (bf16*)(KWS() + WS_H1B), KIN(18), KIN(19), TG, fresh_s(G), fresh_s(c), wv);
#endif
        xcd_barrier(bar);
#if PH_P7
        {
            pg8::Gemm g{(const bf16*)(KWS() + WS_H1B), (const bf16*)(KWS() + WS_WGU), TG, NGU, 1024, 1024};
            pg8::StaticOrder So; So.init(TG, NGU, fresh_s(G), fresh_s(c));
            EpiGU E{(bf16*)(KWS() + WS_HID)};
            pg8::gemm_phase<EpiGU, pg8::StaticOrder, true, true>(lds, g, So, E, wv);
        }
#endif
        xcd_barrier(bar);
#if PH_P8
        {
            pg8::Gemm g{(const bf16*)(KWS() + WS_HID), (const bf16*)(KWS() + WS_WD), TG, 1024, DFF, DFF};
            pg8::StaticOrder So; So.init(TG, 1024, fresh_s(G), fresh_s(c));
            EpiResid E{(const float*)(KWS() + WS_PRE1), KOUT() + (size_t)grp * TG * 1024, DBG_EXP == 6 ? 0.f : 1.f};
            pg8::gemm_phase<EpiResid, pg8::StaticOrder, true, true>(lds, g, So, E, wv);
        }
#endif
        xcd_barrier(bar);
        { float* outg = KOUT() + (size_t)grp * TG * 1024;
        ln_rows(outg, outg, nullptr, KIN(23), KIN(24), TG, fresh_s(G), fresh_s(c), wv, DBG_CHK ? 1.f + (float)__hip_atomic_load((unsigned*)(KWS() + WS_CTL) + 8, __ATOMIC_RELAXED, __HIP_MEMORY_SCOPE_AGENT) + (float)__hip_atomic_load((unsigned*)(KWS() + WS_CTL) + 9, __ATOMIC_RELAXED, __HIP_MEMORY_SCOPE_AGENT) * (1.f / DBG_NDIV) : 1.f); }
    }
}

extern "C" void kernel_launch(void* const* d_in, const int* in_sizes, int n_in, void* d_out, int out_size, void* d_ws, size_t ws_size, hipStream_t stream) {
    static int grid = 0;
    if (grid == 0) {
        if (n_in != 25 || in_sizes[0] != BATCH * S * D || out_size != BATCH * S * D || ws_size < WS_END) {
            fprintf(stderr, "kernel_launch: unexpected problem (n_in %d, in0 %d, out %d, ws %zu; need ws >= %zu); nothing launched\n", n_in, n_in > 0 ? in_sizes[0] : -1, out_size, ws_size, (size_t)WS_END);
            grid = -1; return; }
        int dev = 0, cus = 0, per_cu = 0;
        if (hipGetDevice(&dev) != hipSuccess || hipDeviceGetAttribute(&cus, hipDeviceAttributeMultiprocessorCount, dev) != hipSuccess) { grid = -1; return; }
        if (hipFuncSetAttribute((const void*)nsa_hgrn_fwd, hipFuncAttributeMaxDynamicSharedMemorySize, LDS_BYTES) != hipSuccess) { fprintf(stderr, "kernel_launch: hipFuncSetAttribute failed\n"); grid = -1; return; }
        if (hipOccupancyMaxActiveBlocksPerMultiprocessor(&per_cu, (const void*)nsa_hgrn_fwd, 512, LDS_BYTES) != hipSuccess || per_cu < 1)
            fprintf(stderr, "kernel_launch: note: occupancy query reports %d workgroups per CU\n", per_cu);
        (void)hipGetLastError();
        grid = cus;
    }
    if (grid < 0) return;
    if (hipMemsetAsync((char*)d_ws + WS_CTL, 0, CTL_ZERO_BYTES, stream) != hipSuccess) return;
    Args a{};
    for (int i = 0; i < 25; ++i) a.in[i] = d_in[i];
    a.out = (float*)d_out; a.ws = (unsigned char*)d_ws;
    hipLaunchKernelGGL(nsa_hgrn_fwd, dim3(grid), dim3(512), LDS_BYTES, stream, a);
}
```

```cpp
#include <hip/hip_runtime.h>
#include <cstdio>
#include <cstdint>
#ifndef DBG_EXP
#define DBG_EXP 0
#endif
#ifndef DBG_CHK
#define DBG_CHK 0
#endif
#ifndef DUP_NSA
#define DUP_NSA 0
#endif
#ifndef DUP_HG
#define DUP_HG 0
#endif
#ifndef DBG_SUB
#define DBG_SUB 7
#endif
#ifndef DBG_NBAD
#define DBG_NBAD 5
#endif
#ifndef DBG_DELAY
#define DBG_DELAY 0
#endif
#ifndef DBG_NDIV
#define DBG_NDIV 256.f
#endif
namespace pg8 {
#define PG8_LAS __attribute__((address_space(3)))
typedef unsigned short bf16_t;
typedef short bf16x8 __attribute__((ext_vector_type(8)));
typedef float f32x4 __attribute__((ext_vector_type(4)));
typedef unsigned u32x4 __attribute__((ext_vector_type(4)));
constexpr int BM = 256, BK = 64, HALF = 128, HTB = HALF * BK * 2  , STAGE_BYTES = 8 * HTB, NXCD = 8, WGM = 8;

__host__ __device__ __forceinline__ int lds_byte(int r, int c) { const int st = (r >> 4) * 2 + (c >> 5), rr = r & 15, cc = c & 31, ob = rr * 64 + cc * 2; return st * 1024 + (ob ^ (((ob >> 9) & 1) << 5)); }
__host__ __device__ __forceinline__ void stage_rc(int b, int& R, int& C) { const int st = b / 1024, sb = b % 1024, swz = sb ^ (((sb >> 9) & 1) << 5); R = (st >> 1) * 16 + swz / 64; C = (st & 1) * 32 + (swz % 64) / 2; }
__host__ __device__ __forceinline__ int perm32(int rho) { const int n = rho >> 4, i = rho & 15; return 8 * (i >> 2) + 4 * n + (i & 3); }

struct Unit { int pm, pn; };
struct Gemm { const bf16_t* A; const bf16_t* Bt; int M, N, K, lda; };

struct StaticOrder {
    int nM, nN, nwg, G, c;
    __host__ __device__ void init(int M, int N, int G_, int c_) { nM = M / BM; nN = N / BM; nwg = nM * nN; G = G_; c = c_; }
    __host__ __device__ bool next(int i, Unit& u) const {
        const long L = (long)i * G + c; if (L >= nwg) return false;
        int wgid = (int)L; { const int q = nwg / NXCD, r = nwg % NXCD, xcd = wgid % NXCD, off = wgid / NXCD; wgid = (xcd < r ? xcd * (q + 1) : r * (q + 1) + (xcd - r) * q) + off; }
        const int nig = WGM * nN, gid = wgid / nig, fm = gid * WGM, gsz = (nM - fm) < WGM ? (nM - fm) : WGM;
        u.pm = fm + ((wgid % nig) % gsz); u.pn = (wgid % nig) / gsz; return true;
    }
    __device__ __forceinline__ void a_ready(const Unit&) const {}
    __device__ __forceinline__ void done(const Unit&) const {}
};

__device__ __forceinline__ unsigned cvt_pk_bf16(float lo, float hi) { unsigned r; asm volatile("v_cvt_pk_bf16_f32 %0, %1, %2" : "=v"(r) : "v"(lo), "v"(hi)); return r; }
template <class Epi, class Sched, bool ALIGN_EPI = false, bool SP2 = false>
__device__ __forceinline__ void gemm_phase(PG8_LAS unsigned char* lds, const Gemm g, const Sched& S, const Epi& E, const int wv) {
    unsigned z_ = 0u; asm volatile("" : "+v"(z_)); const int tid = (wv << 6) | (int)__builtin_amdgcn_mbcnt_hi(~0u, __builtin_amdgcn_mbcnt_lo(~0u, z_)), wid = __builtin_amdgcn_readfirstlane(tid >> 6), lane = tid & 63, wr = wid >> 2, wc = wid & 3, fr = lane & 15, fq = lane >> 4;
    const int K = g.K, nt = K / BK;
    unsigned voffA[2], voffB[2];
#pragma unroll
    for (int i = 0; i < 2; ++i) { int R, C; stage_rc(tid * 16 + i * 8192, R, C); const int Rb = Epi::PERM ? ((R & ~31) + perm32(R & 31)) : R;
        voffA[i] = (unsigned)(R * g.lda + C) * 2u; voffB[i] = (unsigned)(Rb * K + C) * 2u; }
    const size_t kstep = (size_t)(BK * 2);
    const size_t hstepA = (size_t)HALF * g.lda * 2, hstepB = (size_t)HALF * K * 2;
    const size_t tstepA = 2 * hstepA, tstepB = 2 * hstepB;
    const unsigned ldsw = (unsigned)wid * 1024u;
    const int aoff = lds_byte(wr * 64 + fr, fq * 8), boff = lds_byte(wc * 32 + fr, fq * 8);
#define PG8_SA(b, h) (((b) * 2 + (h)) * HTB)
#define PG8_SB(b, h) ((4 + (b) * 2 + (h)) * HTB)
#define PG8_STAGE(bufoff, gbase, voff) do { _Pragma("unroll") for (int _i = 0; _i < 2; ++_i) \
        __builtin_amdgcn_global_load_lds((const unsigned*)((const char*)(gbase) + (voff)[_i]), (PG8_LAS unsigned*)(lds + (bufoff) + ldsw + _i * 8192), 16, 0, 0); } while (0)
#define PG8_LDA(dst, b, h) do { _Pragma("unroll") for (int m = 0; m < 4; ++m) _Pragma("unroll") for (int k = 0; k < 2; ++k) dst[m][k] = *(const PG8_LAS bf16x8*)(lds + PG8_SA(b, h) + aoff + m * 2048 + k * 1024); } while (0)
#define PG8_LDB(dst, b, h) do { _Pragma("unroll") for (int n = 0; n < 2; ++n) _Pragma("unroll") for (int k = 0; k < 2; ++k) dst[n][k] = *(const PG8_LAS bf16x8*)(lds + PG8_SB(b, h) + boff + n * 2048 + k * 1024); } while (0)
#define PG8_MMA(ai, bj, At, Bt) do { __builtin_amdgcn_s_setprio(1); _Pragma("unroll") for (int m = 0; m < 4; ++m) _Pragma("unroll") for (int n = 0; n < 2; ++n) _Pragma("unroll") for (int k = 0; k < 2; ++k) \
        acc[ai][bj][m][n] = __builtin_amdgcn_mfma_f32_16x16x32_bf16(Bt[n][k], At[m][k], acc[ai][bj][m][n], 0, 0, 0); __builtin_amdgcn_s_setprio(0); } while (0)
#define PG8_WAIT_V(n) asm volatile("s_waitcnt vmcnt(" #n ")" ::: "memory")
#define PG8_WAIT_L(n) asm volatile("s_waitcnt lgkmcnt(" #n ")" ::: "memory")
#define PG8_BAR __builtin_amdgcn_s_barrier()
#define PG8_SCHED __builtin_amdgcn_sched_barrier(0)
    Unit cur, nxt; int ui = 0;
    if (!S.next(0, cur)) return;
    f32x4 acc[2][2][4][2];
#pragma unroll
    for (int a = 0; a < 2; ++a)
#pragma unroll
        for (int b = 0; b < 2; ++b)
#pragma unroll
            for (int m = 0; m < 4; ++m)
#pragma unroll
                for (int n = 0; n < 2; ++n) acc[a][b][m][n] = (f32x4){0.f, 0.f, 0.f, 0.f};
    bf16x8 At[4][2], B0[2][2], B1[2][2];
    const char* cA = (const char*)g.A + (size_t)cur.pm * tstepA; const char* cB = (const char*)g.Bt + (size_t)cur.pn * tstepB;
    S.a_ready(cur);
    if constexpr (SP2) {
        PG8_STAGE(PG8_SB(0, 0), cB, voffB); PG8_STAGE(PG8_SB(0, 1), cB + hstepB, voffB); PG8_STAGE(PG8_SA(0, 0), cA, voffA); PG8_STAGE(PG8_SA(0, 1), cA + hstepA, voffA);
        if (wr == 1) PG8_BAR;
        PG8_WAIT_V(2); PG8_BAR;
        PG8_STAGE(PG8_SB(1, 0), cB + kstep, voffB); PG8_STAGE(PG8_SA(1, 0), cA + kstep, voffA); PG8_STAGE(PG8_SB(1, 1), cB + hstepB + kstep, voffB);
        PG8_WAIT_V(6); PG8_BAR;
    } else {
        PG8_STAGE(PG8_SB(0, 0), cB, voffB); PG8_STAGE(PG8_SA(0, 0), cA, voffA); PG8_STAGE(PG8_SB(0, 1), cB + hstepB, voffB); PG8_STAGE(PG8_SA(0, 1), cA + hstepA, voffA);
        if (wr == 1) PG8_BAR;
        PG8_WAIT_V(4); PG8_BAR;
        PG8_STAGE(PG8_SB(1, 0), cB + kstep, voffB); PG8_STAGE(PG8_SA(1, 0), cA + kstep, voffA); PG8_STAGE(PG8_SB(1, 1), cB + hstepB + kstep, voffB);
        PG8_WAIT_V(6); PG8_BAR;
    }
    for (;;) {
        const bool has_next = S.next(ui + 1, nxt);
        const char* nA = has_next ? (const char*)g.A + (size_t)nxt.pm * tstepA : cA; const char* nB = has_next ? (const char*)g.Bt + (size_t)nxt.pn * tstepB : cB;
        for (int t = 0; t < nt; t += 2) {
            const bool last = (t == nt - 2);
            const char* a1 = cA + (size_t)(t + 1) * kstep;
            const char* a2 = last ? nA : cA + (size_t)(t + 2) * kstep; const char* b2 = last ? nB : cB + (size_t)(t + 2) * kstep;
            const char* a3 = a2 + kstep; const char* b3 = b2 + kstep;
            if (last && has_next) S.a_ready(nxt);
            if constexpr (SP2) {
            PG8_LDB(B0, 0, 0); PG8_LDB(B1, 0, 1); PG8_SCHED; PG8_LDA(At, 0, 0); PG8_STAGE(PG8_SA(1, 1), a1 + hstepA, voffA);
            PG8_WAIT_V(8); PG8_WAIT_L(0); PG8_BAR; PG8_MMA(0, 0, At, B0); PG8_MMA(0, 1, At, B1); PG8_BAR; PG8_SCHED;
            PG8_LDA(At, 0, 1); PG8_STAGE(PG8_SB(0, 0), b2, voffB); PG8_STAGE(PG8_SB(0, 1), b2 + hstepB, voffB); PG8_STAGE(PG8_SA(0, 0), a2, voffA);
            PG8_WAIT_V(8); PG8_WAIT_L(0); PG8_BAR; PG8_MMA(1, 0, At, B0); PG8_MMA(1, 1, At, B1); PG8_BAR; PG8_SCHED;
            PG8_LDB(B0, 1, 0); PG8_LDB(B1, 1, 1); PG8_SCHED; PG8_LDA(At, 1, 0); PG8_STAGE(PG8_SA(0, 1), a2 + hstepA, voffA);
            PG8_WAIT_V(8); PG8_WAIT_L(0); PG8_BAR; PG8_MMA(0, 0, At, B0); PG8_MMA(0, 1, At, B1); PG8_BAR; PG8_SCHED;
            PG8_LDA(At, 1, 1); PG8_STAGE(PG8_SB(1, 0), b3, voffB); PG8_STAGE(PG8_SB(1, 1), b3 + hstepB, voffB); PG8_STAGE(PG8_SA(1, 0), a3, voffA);
            PG8_WAIT_V(8); PG8_WAIT_L(0); PG8_BAR; PG8_MMA(1, 0, At, B0); PG8_MMA(1, 1, At, B1); PG8_BAR; PG8_SCHED;
            } else {
            PG8_LDB(B0, 0, 0); PG8_SCHED; PG8_LDA(At, 0, 0); PG8_STAGE(PG8_SA(1, 1), a1 + hstepA, voffA);
            PG8_WAIT_L(8); PG8_BAR; PG8_WAIT_L(0); PG8_MMA(0, 0, At, B0); PG8_BAR; PG8_SCHED;
            PG8_LDB(B1, 0, 1); PG8_STAGE(PG8_SB(0, 0), b2, voffB);
            PG8_BAR; PG8_WAIT_L(0); PG8_MMA(0, 1, At, B1); PG8_BAR;
            PG8_LDA(At, 0, 1); PG8_STAGE(PG8_SA(0, 0), a2, voffA);
            PG8_BAR; PG8_WAIT_L(0); PG8_MMA(1, 0, At, B0); PG8_BAR; PG8_SCHED;
            PG8_STAGE(PG8_SB(0, 1), b2 + hstepB, voffB);
            PG8_WAIT_V(6); PG8_BAR; PG8_MMA(1, 1, At, B1); PG8_BAR;
            PG8_LDB(B0, 1, 0); PG8_SCHED; PG8_LDA(At, 1, 0); PG8_STAGE(PG8_SA(0, 1), a2 + hstepA, voffA);
            PG8_WAIT_L(8); PG8_BAR; PG8_WAIT_L(0); PG8_MMA(0, 0, At, B0); PG8_BAR; PG8_SCHED;
            PG8_LDB(B1, 1, 1); PG8_STAGE(PG8_SB(1, 0), b3, voffB);
            PG8_BAR; PG8_WAIT_L(0); PG8_MMA(0, 1, At, B1); PG8_BAR;
            PG8_LDA(At, 1, 1); PG8_STAGE(PG8_SA(1, 0), a3, voffA);
            PG8_BAR; PG8_WAIT_L(0); PG8_MMA(1, 0, At, B0); PG8_BAR; PG8_SCHED;
            PG8_STAGE(PG8_SB(1, 1), b3 + hstepB, voffB);
            PG8_WAIT_V(6); PG8_BAR; PG8_MMA(1, 1, At, B1); PG8_BAR;
            }
        }
        if constexpr (ALIGN_EPI) { if (wr == 0) PG8_BAR; }
        if constexpr (!Epi::AFTER_DRAIN) { E(acc, cur, wr, wc, fr, fq); S.done(cur); }
        if (!has_next) break;
#pragma unroll
        for (int a = 0; a < 2; ++a)
#pragma unroll
            for (int b = 0; b < 2; ++b)
#pragma unroll
                for (int m = 0; m < 4; ++m)
#pragma unroll
                    for (int n = 0; n < 2; ++n) acc[a][b][m][n] = (f32x4){0.f, 0.f, 0.f, 0.f};
        cur = nxt; cA = nA; cB = nB; ++ui;
        if constexpr (ALIGN_EPI) { if (wr == 1) PG8_BAR; }
    }
    PG8_WAIT_V(0);
    if constexpr (!ALIGN_EPI) { if (wr == 0) PG8_BAR; }
    PG8_BAR;
    if constexpr (Epi::AFTER_DRAIN) { E.fused(acc, cur, wr, wc, fr, fq, lds, wid, lane); S.done(cur); }
#undef PG8_SA
#undef PG8_SB
#undef PG8_STAGE
#undef PG8_LDA
#undef PG8_LDB
#undef PG8_MMA
#undef PG8_WAIT_V
#undef PG8_WAIT_L
#undef PG8_BAR
#undef PG8_SCHED
}
}

constexpr int S = 2048, D = 1024, BATCH = 32, BG = 16, NGRP = BATCH / BG, TG = BG * S;
constexpr int NPROJ = 8960, NSRC = 8752, DFF = 2816, NGU = 2 * DFF;
constexpr float DN_ALPHA = 1.189207115002721f, LN_EPS = 1e-5f, RMS_EPS = 1e-6f;
constexpr float SM_C = 0.125f * 1.4426950408889634f;
constexpr float NEG_BIG = -1e30f;

constexpr size_t MiB = 1u << 20;
constexpr size_t WS_CTL = 0, CTL_ZERO_BYTES = 1 * MiB;
constexpr size_t WS_WIN = 1 * MiB, WS_WA = 19 * MiB, WS_WB = 21 * MiB, WS_WO = 23 * MiB, WS_WGU = 25 * MiB, WS_WD = 36 * MiB, WS_CW1 = 42 * MiB, WS_CW2 = 44 * MiB;
constexpr size_t WS_VEC = 45 * MiB, WS_ROPE = 46 * MiB;
constexpr size_t WS_XB = 64 * MiB, WS_MERGED = 64 * MiB;
constexpr size_t WS_HQ = 128 * MiB, WS_HF = 192 * MiB, WS_HI = 256 * MiB, WS_HG = 320 * MiB, WS_NQ = 384 * MiB;
constexpr size_t WS_KC = 448 * MiB, WS_VC = 464 * MiB, WS_KS = 480 * MiB, WS_VST = 496 * MiB, WS_KW = 512 * MiB, WS_VWT = 528 * MiB, WS_ORAW = 544 * MiB;
constexpr size_t WS_PRE1 = 128 * MiB, WS_H1B = 256 * MiB, WS_HID = 320 * MiB;
constexpr size_t WS_GA = 608 * MiB, WS_GB = 672 * MiB, WS_GATES = 736 * MiB, WS_HC = 742 * MiB, WS_KCMP = 750 * MiB, WS_VCMPT = 751 * MiB;
constexpr size_t WS_AOUT = 752 * MiB, WS_BOUT = 816 * MiB, WS_END = 880 * MiB;
static_assert(WS_HF == WS_HQ + 64 * MiB && WS_HI == WS_HQ + 128 * MiB && WS_HG == WS_HQ + 192 * MiB && WS_VC == WS_KC + 16 * MiB && WS_KS == WS_KC + 32 * MiB && WS_VST == WS_KC + 48 * MiB && WS_KW == WS_KC + 64 * MiB && WS_VWT == WS_KC + 80 * MiB && WS_GB == WS_GA + 64 * MiB, "EpiProj destination arithmetic");
constexpr int VEC_LB = 0, VEC_CB1 = 1024, VEC_CB2 = 1536;
constexpr int CW_BAR = 4096;

constexpr int RING_BYTES = 131072, LDSCTL_OFF = RING_BYTES, MISC_OFF = LDSCTL_OFF + 320, LDS_BYTES = 147456;

#define GAS __attribute__((address_space(1)))
#define LAS __attribute__((address_space(3)))
typedef unsigned short bf16;
typedef unsigned v4u __attribute__((ext_vector_type(4)));
typedef unsigned v2u __attribute__((ext_vector_type(2)));
typedef float f32x4 __attribute__((ext_vector_type(4)));
typedef float f32x2 __attribute__((ext_vector_type(2)));
typedef short bf16x8 __attribute__((ext_vector_type(8)));
typedef __bf16 bf16v2 __attribute__((ext_vector_type(2)));
typedef _Float16 f16v2 __attribute__((ext_vector_type(2)));
typedef GAS unsigned gu32;
#define RLX_AGENT __ATOMIC_RELAXED, __HIP_MEMORY_SCOPE_AGENT
#define LDS_WAIT() asm volatile("s_waitcnt lgkmcnt(0)" ::: "memory")
#define VM_WAIT() asm volatile("s_waitcnt vmcnt(0)" ::: "memory")

__device__ __forceinline__ int fresh_tid(int wv) { unsigned z = 0u; asm volatile("" : "+v"(z)); return (wv << 6) | (int)__builtin_amdgcn_mbcnt_hi(~0u, __builtin_amdgcn_mbcnt_lo(~0u, z)); }
__device__ __forceinline__ int fresh_s(int v) { asm volatile("" : "+s"(v)); return __builtin_amdgcn_readfirstlane(v); }
__device__ __forceinline__ unsigned pk2(float lo, float hi) { f32x2 v = {lo, hi}; bf16v2 r = __builtin_convertvector(v, bf16v2); return __builtin_bit_cast(unsigned, r); }
__device__ __forceinline__ unsigned pkh2(float lo, float hi) { f32x2 v = {lo, hi}; f16v2 r = __builtin_convertvector(v, f16v2); return __builtin_bit_cast(unsigned, r); }
__device__ __forceinline__ float h2f_lo(unsigned u) { return (float)__builtin_bit_cast(_Float16, (unsigned short)(u & 0xffffu)); }
__device__ __forceinline__ float h2f_hi(unsigned u) { return (float)__builtin_bit_cast(_Float16, (unsigned short)(u >> 16)); }
__device__ __forceinline__ float bflo(unsigned u) { return __uint_as_float(u << 16); }
__device__ __forceinline__ float bfhi(unsigned u) { return __uint_as_float(u & 0xffff0000u); }
__device__ __forceinline__ float fexp(float x) { return __builtin_amdgcn_exp2f(x * 1.4426950408889634f); }
__device__ __forceinline__ float frcp(float x) { return __builtin_amdgcn_rcpf(x); }
__device__ __forceinline__ float flog(float x) { return __builtin_amdgcn_logf(x) * 0.6931471805599453f; }
__device__ __forceinline__ float frsq(float x) { return __builtin_amdgcn_rsqf(x); }
__device__ __forceinline__ float sigm(float z) { return frcp(1.0f + fexp(-z)); }
__device__ __forceinline__ float siluf(float z) { return z * frcp(1.0f + fexp(-z)); }
template <int CTRL> __device__ __forceinline__ float dppf(float v) { return __builtin_bit_cast(float, __builtin_amdgcn_update_dpp(0, __builtin_bit_cast(int, v), CTRL, 0xF, 0xF, true)); }
__device__ __forceinline__ float sum4(float v) { v += dppf<0xB1>(v); v += dppf<0x4E>(v); return v; }
__device__ __forceinline__ float sum8(float v) { v = sum4(v); v += dppf<0x141>(v); return v; }
__device__ __forceinline__ float sum16(float v) { v = sum8(v); v += dppf<0x140>(v); return v; }
__device__ __forceinline__ float wave_sum(float v) {
#pragma unroll
    for (int o = 1; o < 64; o <<= 1) v += __shfl_xor(v, o);
    return v;
}

typedef __attribute__((address_space(4))) const unsigned long long* kargp_t;
__device__ __forceinline__ const void* karg(int i) {
    const unsigned long long p = (unsigned long long)__builtin_amdgcn_kernarg_segment_ptr();
    unsigned lo = (unsigned)p, hi = (unsigned)(p >> 32);
    asm volatile("" : "+s"(lo), "+s"(hi));
    lo = __builtin_amdgcn_readfirstlane(lo); hi = __builtin_amdgcn_readfirstlane(hi);
    const kargp_t ka = (kargp_t)(((unsigned long long)hi << 32) | lo);
    return (const void*)ka[i];
}
#define KIN(i) ((const float*)karg(i))
#define KOUT() ((float*)karg(25))
#define KWS() ((unsigned char*)karg(26))
#define XB_TMO      128
#define XB_XCNT(j)  (256  + 64 * (j))
#define XB_XSUB(j)  (1280 + 64 * (j))
#define XB_XGEN(j)  (2304 + 64 * (j))
#define XB_TOP      3328
#define XB_TOPGEN   3392
#define XCD_BAR_WORDS 3456
#define XB_SPIN_CAP (DBG_CHK ? (1u << 26) : (1u << 22))

__device__ __forceinline__ unsigned xb_ld(unsigned* p)              { return __hip_atomic_load(p, __ATOMIC_RELAXED, __HIP_MEMORY_SCOPE_AGENT); }
__device__ __forceinline__ unsigned xb_add(unsigned* p, unsigned v) { return __hip_atomic_fetch_add(p, v, __ATOMIC_RELAXED, __HIP_MEMORY_SCOPE_AGENT); }
__device__ __forceinline__ unsigned xb_xcc_id() { return (unsigned)__builtin_amdgcn_s_getreg((3 << 11) | 20) & 0xFu; }
#define XB_SPIN(cond, bar) do { unsigned _sp = 0; while (cond) { __builtin_amdgcn_s_sleep(1); \
    if ((++_sp & 255u) == 0u) { if (xb_ld(&(bar)[XB_TMO])) break; if (_sp > XB_SPIN_CAP) { atomicAdd(&(bar)[XB_TMO], 1u); break; } } } } while (0)

struct XcdBarrier { unsigned* bar; unsigned x; volatile LAS unsigned* st; };

__device__ __forceinline__ XcdBarrier xcd_barrier_post(unsigned* bar, volatile LAS unsigned* st) {
    XcdBarrier b; b.bar = bar; b.x = xb_xcc_id(); b.st = st;
    if (threadIdx.x == 0) (void)xb_add(&bar[XB_XCNT(b.x)], 1u);
    return b;
}
__device__ __forceinline__ void xcd_barrier_complete(unsigned* bar, unsigned x, unsigned& nloc, unsigned& nx) {
    const unsigned G = gridDim.x * gridDim.y * gridDim.z;
    unsigned sum, cnt, mine, sp = 0u;
    for (;;) {
        sum = 0u; cnt = 0u; mine = 0u;
#pragma unroll 1
        for (unsigned j = 0; j < 16; ++j) { const unsigned c = xb_ld(&bar[XB_XCNT(j)]); sum += c; cnt += (c > 0u) ? 1u : 0u; mine = (j == x) ? c : mine; }
        if (sum == G) break;
        __builtin_amdgcn_s_sleep(1);
        if ((++sp & 255u) == 0u) { if (xb_ld(&bar[XB_TMO])) break; if (sp > XB_SPIN_CAP) { atomicAdd(&bar[XB_TMO], 1u); break; } }
    }
    nloc = mine > 0u ? mine : 1u; nx = cnt > 0u ? cnt : 1u;
}
__device__ __forceinline__ void xcd_barrier(const XcdBarrier& b) {
    asm volatile("s_waitcnt vmcnt(0)" ::: "memory");
    __syncthreads();
    if (threadIdx.x == 0) {
        unsigned* bar = (unsigned*)(KWS() + WS_CTL) + CW_BAR;
        const unsigned bx = xb_xcc_id();
        __builtin_amdgcn_s_waitcnt(0);
        unsigned nloc = b.st[0], nx = b.st[1];
        if (nloc == 0u) { xcd_barrier_complete(bar, bx, nloc, nx); b.st[0] = nloc; b.st[1] = nx; }
        const unsigned old = xb_add(&bar[XB_XSUB(bx)], 1u);
        const unsigned gen = old / nloc;
        if (old + 1u == (gen + 1u) * nloc) {
            __builtin_amdgcn_fence(__ATOMIC_RELEASE, "agent");
            asm volatile("s_waitcnt vmcnt(0)" ::: "memory");
            const unsigned og = xb_add(&bar[XB_TOP], 1u);
            const unsigned tg = og / nx;
            if (og + 1u == (tg + 1u) * nx) xb_add(&bar[XB_TOPGEN], 1u);
            else XB_SPIN(xb_ld(&bar[XB_TOPGEN]) == tg, bar);
            __builtin_amdgcn_fence(__ATOMIC_ACQUIRE, "agent");
            xb_add(&bar[XB_XGEN(bx)], 1u);
            asm volatile("s_waitcnt vmcnt(0)" ::: "memory");
        } else {
            XB_SPIN(xb_ld(&bar[XB_XGEN(bx)]) == gen, bar);
            __builtin_amdgcn_fence(__ATOMIC_ACQUIRE, "agent");
            asm volatile("s_waitcnt vmcnt(0)" ::: "memory");
        }
    }
    __syncthreads();
}

__device__ __forceinline__ int pi64(int j) { return (j & 1) ? 32 + (j >> 1) : (j >> 1); }
__device__ __forceinline__ bool rope_tile(int t) { return (t >= 16 && t <= 20) || t == 22 || t == 24; }
__device__ __forceinline__ int win_src(int j) {
    const int t = j >> 8;
    if (t < 16) return j;
    if (t < 26) return rope_tile(t) ? ((j & ~63) + pi64(j & 63)) : j;
    if (t < 34) return j + 48;
    const int r = j - 8704; return r < 48 ? 6656 + r : -1;
}
struct SrcWin { const float* w; __device__ __forceinline__ float operator()(int k, int j) const { const int s = win_src(j); return s >= 0 ? w[(size_t)k * NSRC + s] : 0.f; } };
struct SrcPlain { const float* w; int n; __device__ __forceinline__ float operator()(int k, int j) const { return w[(size_t)k * n + j]; } };
struct SrcGU { const float* wg; const float* wu; __device__ __forceinline__ float operator()(int k, int j) const { const int t = j >> 8, r = j & 255; return r < 128 ? wg[(size_t)k * DFF + 128 * t + r] : wu[(size_t)k * DFF + 128 * t + r - 128]; } };
struct SrcCW1 { const float* wk; const float* wv; __device__ __forceinline__ float operator()(int k, int j) const { return j < 256 ? wk[(size_t)((k & ~63) + pi64(k & 63)) * 256 + j] : wv[(size_t)k * 256 + j - 256]; } };
struct SrcCW2 { const float* wk; const float* wv; __device__ __forceinline__ float operator()(int k, int j) const { return j < 64 ? wk[k * 64 + pi64(j)] : ((j >= 256 && j < 320) ? wv[k * 64 + j - 256] : 0.f); } };

template <class F>
__device__ __forceinline__ void tr_item(const F& f, bf16* WT, int K, int N, int item, LAS float* scr, int lane) {
    const int nblk = N / 32, kb = item / nblk, nb = item % nblk, k0 = 64 * kb, n0 = 32 * nb;
#pragma unroll 8
    for (int i = 0; i < 32; ++i) { const int kk = 2 * i + (lane >> 5); scr[kk * 33 + (lane & 31)] = f(k0 + kk, n0 + (lane & 31)); }
    LDS_WAIT(); asm volatile("" ::: "memory");
    const int c = lane & 7;
#pragma unroll
    for (int j = 0; j < 4; ++j) { const int n = (lane >> 3) + 8 * j; const LAS float* s = scr + (8 * c) * 33 + n;
        v4u o; o.x = pk2(s[0 * 33], s[1 * 33]); o.y = pk2(s[2 * 33], s[3 * 33]); o.z = pk2(s[4 * 33], s[5 * 33]); o.w = pk2(s[6 * 33], s[7 * 33]);
        *(v4u*)(WT + (size_t)(n0 + n) * K + k0 + 8 * c) = o; }
    LDS_WAIT(); asm volatile("" ::: "memory");
}

__device__ static const float ROPE_INVF[32] = {
    1.000000000e+00f, 7.498942614e-01f, 5.623413324e-01f, 4.216965139e-01f, 3.162277639e-01f, 2.371373773e-01f, 1.778279394e-01f, 1.333521307e-01f,
    1.000000015e-01f, 7.498941571e-02f, 5.623413250e-02f, 4.216965288e-02f, 3.162277490e-02f, 2.371373773e-02f, 1.778279431e-02f, 1.333521493e-02f,
    9.999999776e-03f, 7.498941850e-03f, 5.623413250e-03f, 4.216964822e-03f, 3.162277630e-03f, 2.371373586e-03f, 1.778279431e-03f, 1.333521446e-03f,
    1.000000047e-03f, 7.498942432e-04f, 5.623413017e-04f, 4.216965172e-04f, 3.162277571e-04f, 2.371373703e-04f, 1.778279402e-04f, 1.333521504e-04f };

__device__ __forceinline__ void sincos_acc(float ang, float& c, float& s) {
    const double a = (double)ang, twopi = 6.283185307179586476925287, inv2pi = 0.15915494309189533576888;
    const double k = __builtin_rint(a * inv2pi), r = a - k * twopi, r2 = r * r;
    double cs = 1.0, sn = 1.0, tc = 1.0, ts = 1.0;
#pragma unroll
    for (int n = 1; n <= 13; ++n) { tc = -tc * r2 / (double)((2 * n - 1) * (2 * n)); ts = -ts * r2 / (double)((2 * n) * (2 * n + 1)); cs += tc; sn += ts; }
    c = (float)cs; s = (float)(sn * r);
}

struct P0Args { const float* const* in; };
using pg8::Unit;
typedef const f32x4 (&AccRef)[2][2][4][2];

__device__ __forceinline__ v4u pack8(const float (&o)[8]) { v4u w; w.x = pk2(o[0], o[1]); w.y = pk2(o[2], o[3]); w.z = pk2(o[4], o[5]); w.w = pk2(o[6], o[7]); return w; }

struct EpiProj {
    static constexpr bool PERM = true, AFTER_DRAIN = false;
    int grp;
    __device__ __forceinline__ void operator()(AccRef acc, const Unit& u, int wr, int wc, int fr, int fq) const {
        const int pn = u.pn, rbase = u.pm * 256 + wr * 64 + fr;
        unsigned char* const ws = KWS();
        const float* const lb = (const float*)(ws + WS_VEC) + VEC_LB;
        const f32x2* const rope = (const f32x2*)(ws + WS_ROPE) + (size_t)grp * TG * 32;
#pragma unroll
        for (int ai = 0; ai < 2; ++ai)
#pragma unroll
            for (int m = 0; m < 4; ++m) {
                const int row = rbase + ai * 128 + m * 16;
                const int b = row >> 11, t = row & 2047;
#pragma unroll
                for (int bj = 0; bj < 2; ++bj) {
                    const int c0 = bj * 128 + wc * 32 + fq * 8;
                    float v[8];
#pragma unroll
                    for (int e = 0; e < 4; ++e) { v[e] = acc[ai][bj][m][0][e]; v[4 + e] = acc[ai][bj][m][1][e]; }
                    if (pn < 16) {
                        const int seg = pn >> 2, col = (pn & 3) * 256 + c0;
                        if (seg == 1) {
                            const f32x4 l0 = *(const f32x4*)(lb + col), l1 = *(const f32x4*)(lb + col + 4);
                            float o[8];
#pragma unroll
                            for (int e = 0; e < 8; ++e) { const float lbv = e < 4 ? l0[e] : l1[e - 4]; o[e] = flog(lbv + (1.0f - lbv) * sigm(v[e])); }
                            v4u w; w.x = pkh2(o[0], o[1]); w.y = pkh2(o[2], o[3]); w.z = pkh2(o[4], o[5]); w.w = pkh2(o[6], o[7]);
                            *(v4u*)(ws + (WS_HQ + (size_t)seg * (64 * MiB) + ((size_t)row * 1024 + col) * 2)) = w;
                        } else {
                            *(v4u*)(ws + (WS_HQ + (size_t)seg * (64 * MiB) + ((size_t)row * 1024 + col) * 2)) = pack8(v);
                        }
                    } else if (pn < 26) {
                        const bool rp = rope_tile(pn);
                        float o[8];
                        if (rp) {
                            const int i0 = (c0 & 63) >> 1;
                            const f32x4 cs0 = *(const f32x4*)(rope + (size_t)row * 32 + i0), cs1 = *(const f32x4*)(rope + (size_t)row * 32 + i0 + 2);
                            o[0] = v[0] * cs0[0] - v[1] * cs0[1]; o[1] = v[1] * cs0[0] + v[0] * cs0[1];
                            o[2] = v[2] * cs0[2] - v[3] * cs0[3]; o[3] = v[3] * cs0[2] + v[2] * cs0[3];
                            o[4] = v[4] * cs1[0] - v[5] * cs1[1]; o[5] = v[5] * cs1[0] + v[4] * cs1[1];
                            o[6] = v[6] * cs1[2] - v[7] * cs1[3]; o[7] = v[7] * cs1[2] + v[6] * cs1[3];
                        } else {
#pragma unroll
                            for (int e = 0; e < 8; ++e) o[e] = v[e];
                        }
                        const int hd = c0 >> 6, jh = c0 & 63;
                        if (pn < 20) {
                            const int head = (pn - 16) * 4 + hd;
#pragma unroll
                            for (int e = 0; e < 8; ++e) o[e] *= SM_C;
                            *(v4u*)((bf16*)(ws + WS_NQ) + ((size_t)(b * 16 + head) * S + t) * 64 + jh) = pack8(o);
                        } else if (pn == 23 || pn == 25) {
                            bf16* dst = (bf16*)(ws + (WS_KC + (size_t)(pn - 20) * (16 * MiB) + (((size_t)(b * 4 + hd) * 64 + jh) * S + t) * 2));
#pragma unroll
                            for (int e = 0; e < 8; ++e) dst[(size_t)e * S] = (bf16)(pk2(o[e], 0.f) & 0xffffu);
                        } else {
                            *(v4u*)(ws + (WS_KC + (size_t)(pn - 20) * (16 * MiB) + (((size_t)(b * 4 + hd) * S + t) * 64 + jh) * 2)) = pack8(o);
                        }
                    } else if (pn < 34) {
                        float o[8];
#pragma unroll
                        for (int e = 0; e < 8; ++e) o[e] = sigm(v[e]);
                        *(v4u*)(ws + (WS_GA + (size_t)((pn - 26) >> 2) * (64 * MiB) + ((size_t)row * 1024 + ((pn - 26) & 3) * 256 + c0) * 2)) = pack8(o);
                    } else {
                        if (c0 < 48) {
                            float* dst = (float*)(ws + WS_GATES) + (size_t)row * 48 + c0;
                            *(f32x4*)dst = (f32x4){sigm(v[0]), sigm(v[1]), sigm(v[2]), sigm(v[3])};
                            *(f32x4*)(dst + 4) = (f32x4){sigm(v[4]), sigm(v[5]), sigm(v[6]), sigm(v[7])};
                        }
                    }
                    asm volatile("" ::: "memory");
                }
            }
    }
};

struct EpiCmp1 {
    static constexpr bool PERM = true, AFTER_DRAIN = false;
    bf16* HC; const float* cb1;
    __device__ __forceinline__ void operator()(AccRef acc, const Unit& u, int wr, int wc, int fr, int fq) const {
        const int rbase = u.pm * 256 + wr * 64 + fr;
#pragma unroll
        for (int bj = 0; bj < 2; ++bj) {
            const int c0 = bj * 128 + wc * 32 + fq * 8;
            const f32x4 b0 = *(const f32x4*)(cb1 + u.pn * 256 + c0), b1 = *(const f32x4*)(cb1 + u.pn * 256 + c0 + 4);
#pragma unroll
            for (int ai = 0; ai < 2; ++ai)
#pragma unroll
                for (int m = 0; m < 4; ++m) {
                    const int row = rbase + ai * 128 + m * 16;
                    float o[8];
#pragma unroll
                    for (int e = 0; e < 4; ++e) { o[e] = siluf(acc[ai][bj][m][0][e] + b0[e]); o[4 + e] = siluf(acc[ai][bj][m][1][e] + b1[e]); }
                    *(v4u*)(HC + (size_t)row * 256 + c0) = pack8(o);
                }
        }
    }
};
struct EpiCmp2 {
    static constexpr bool PERM = true, AFTER_DRAIN = false;
    bf16* KCMP; bf16* VCMPT; const float* cb2;
    __device__ __forceinline__ void operator()(AccRef acc, const Unit& u, int wr, int wc, int fr, int fq) const {
        if (wc >= 2) return;
        const int c0 = wc * 32 + fq * 8, rbase = u.pm * 256 + wr * 64 + fr;
        const f32x4 b0 = *(const f32x4*)(cb2 + u.pn * 256 + c0), b1 = *(const f32x4*)(cb2 + u.pn * 256 + c0 + 4);
#pragma unroll
        for (int ai = 0; ai < 2; ++ai)
#pragma unroll
            for (int m = 0; m < 4; ++m) {
                const int row = rbase + ai * 128 + m * 16;
                float o[8];
#pragma unroll
                for (int e = 0; e < 4; ++e) { o[e] = acc[ai][0][m][0][e] + b0[e]; o[4 + e] = acc[ai][0][m][1][e] + b1[e]; }
                if (u.pn == 0) *(v4u*)(KCMP + (size_t)row * 64 + c0) = pack8(o);
                else { const int r2 = row - 8192, bh = r2 >> 7, n = r2 & 127; bf16* dst = VCMPT + ((size_t)bh * 64 + c0) * 128 + n;
#pragma unroll
                    for (int e = 0; e < 8; ++e) dst[e * 128] = (bf16)(pk2(o[e], 0.f) & 0xffffu); }
            }
    }
};
template <bool ACCUM> struct EpiMerge {
    static constexpr bool PERM = true, AFTER_DRAIN = false;
    __device__ __forceinline__ void operator()(AccRef acc, const Unit& u, int wr, int wc, int fr, int fq) const {
        const int rbase = u.pm * 256 + wr * 64 + fr;
        unsigned char* const ws = KWS();
        const bf16* const GT = (const bf16*)(ws + (ACCUM ? WS_GB : WS_GA)); bf16* const MG = (bf16*)(ws + WS_MERGED);
#pragma unroll
        for (int ai = 0; ai < 2; ++ai)
#pragma unroll
            for (int m = 0; m < 4; ++m) {
                const int row = rbase + ai * 128 + m * 16;
#pragma unroll
                for (int bj = 0; bj < 2; ++bj) {
                    const size_t off = (size_t)row * 1024 + u.pn * 256 + bj * 128 + wc * 32 + fq * 8;
                    const v4u gt = *(const v4u*)(GT + off);
                    float o[8];
                    o[0] = bflo(gt.x) * acc[ai][bj][m][0][0]; o[1] = bfhi(gt.x) * acc[ai][bj][m][0][1]; o[2] = bflo(gt.y) * acc[ai][bj][m][0][2]; o[3] = bfhi(gt.y) * acc[ai][bj][m][0][3];
                    o[4] = bflo(gt.z) * acc[ai][bj][m][1][0]; o[5] = bfhi(gt.z) * acc[ai][bj][m][1][1]; o[6] = bflo(gt.w) * acc[ai][bj][m][1][2]; o[7] = bfhi(gt.w) * acc[ai][bj][m][1][3];
                    if (ACCUM) { const v4u pv = *(const v4u*)(MG + off);
                        o[0] += bflo(pv.x); o[1] += bfhi(pv.x); o[2] += bflo(pv.y); o[3] += bfhi(pv.y); o[4] += bflo(pv.z); o[5] += bfhi(pv.z); o[6] += bflo(pv.w); o[7] += bfhi(pv.w); }
                    *(v4u*)(MG + off) = pack8(o);
                }
                asm volatile("" ::: "memory");
            }
    }
};
struct EpiResid {
    static constexpr bool PERM = false, AFTER_DRAIN = false;
    const float* res; float* out; float scale;
    __device__ __forceinline__ void operator()(AccRef acc, const Unit& u, int wr, int wc, int fr, int fq) const {
        const int rbase = u.pm * 256 + wr * 64 + fr;
#pragma unroll
        for (int ai = 0; ai < 2; ++ai)
#pragma unroll
            for (int m = 0; m < 4; ++m) {
                const int row = rbase + ai * 128 + m * 16;
#pragma unroll
                for (int bj = 0; bj < 2; ++bj)
#pragma unroll
                    for (int n = 0; n < 2; ++n) {
                        const size_t off = (size_t)row * 1024 + u.pn * 256 + bj * 128 + wc * 32 + n * 16 + fq * 4;
                        const f32x4 r = *(const f32x4*)(res + off);
                        *(f32x4*)(out + off) = r * DN_ALPHA + acc[ai][bj][m][n] * scale;
                    }
                asm volatile("" ::: "memory");
            }
    }
};
struct EpiGU {
    static constexpr bool PERM = true, AFTER_DRAIN = false;
    bf16* HID;
    __device__ __forceinline__ void operator()(AccRef acc, const Unit& u, int wr, int wc, int fr, int fq) const {
        const int rbase = u.pm * 256 + wr * 64 + fr;
#pragma unroll
        for (int ai = 0; ai < 2; ++ai)
#pragma unroll
            for (int m = 0; m < 4; ++m) {
                const int row = rbase + ai * 128 + m * 16;
                float o[8];
#pragma unroll
                for (int e = 0; e < 4; ++e) { o[e] = siluf(acc[ai][0][m][0][e]) * acc[ai][1][m][0][e]; o[4 + e] = siluf(acc[ai][0][m][1][e]) * acc[ai][1][m][1][e]; }
                *(v4u*)(HID + (size_t)row * DFF + u.pn * 128 + wc * 32 + fq * 8) = pack8(o);
            }
    }
};
struct OneUnit {
    int pm, pn; bool has;
    __device__ __forceinline__ bool next(int i, Unit& u) const { if (i == 0 && has) { u.pm = pm; u.pn = pn; return true; } return false; }
    __device__ __forceinline__ void a_ready(const Unit&) const {}
    __device__ __forceinline__ void done(const Unit&) const {}
};
constexpr int HG_PK = 136, HG_PS = 72;
constexpr int HG_QD = 0, HG_KI = 64 * HG_PK * 2, HG_KET = 2 * 64 * HG_PK * 2, HG_VT = HG_KET + 128 * HG_PS * 2, HG_P = HG_VT + 64 * HG_PS * 2, HG_ST = HG_P + 64 * HG_PS * 2,
              HG_SEG = HG_ST + 64 * HG_PK * 2, HG_END = HG_SEG + 8 * 128 * 4;
static_assert(HG_END <= 131072, "HGRN2 LDS map");
#define MFMA16H(a, b, c) __builtin_amdgcn_mfma_f32_16x16x32_bf16((a), (b), (c), 0, 0, 0)

__device__ __forceinline__ void hgrn_phase(LAS unsigned char* lds, const bf16* HQ, const bf16* HF, const bf16* HI, bf16* ORAW, int G, int c, int wv) {
    const int tid = fresh_tid(wv), lane = tid & 63, wave = __builtin_amdgcn_readfirstlane(tid >> 6), j = lane & 15, fq = lane >> 4;
    LAS bf16* const QD = (LAS bf16*)(lds + HG_QD); LAS bf16* const KI = (LAS bf16*)(lds + HG_KI); LAS bf16* const KET = (LAS bf16*)(lds + HG_KET);
    LAS bf16* const VT = (LAS bf16*)(lds + HG_VT); LAS bf16* const PP = (LAS bf16*)(lds + HG_P); LAS bf16* const ST = (LAS bf16*)(lds + HG_ST);
    LAS float* const SEG = (LAS float*)(lds + HG_SEG);
    const int kp = tid & 63, seg = tid >> 6;
    const int vp = tid & 31, sg = tid >> 5;
    for (int unit = c; unit < BG * 16; unit += G) {
        const int vh = unit & 1, h = (unit >> 1) & 7, b = unit >> 4;
        const size_t row0 = (size_t)b * S;
        const int colq = h * 128, coli = h * 128 + vh * 64;
        typedef const GAS unsigned* gup;
        f32x4 sacc[4];
#pragma unroll
        for (int vb = 0; vb < 4; ++vb) sacc[vb] = (f32x4){0.f, 0.f, 0.f, 0.f};
        unsigned rq[8], rf[8], rv[4];
#pragma unroll
        for (int i = 0; i < 8; ++i) { rq[i] = *(gup)(HQ + (row0 + 8 * seg + i) * 1024 + colq + 2 * kp); rf[i] = *(gup)(HF + (row0 + 8 * seg + i) * 1024 + colq + 2 * kp); }
#pragma unroll
        for (int i = 0; i < 4; ++i) rv[i] = *(gup)(HI + (row0 + 4 * sg + i) * 1024 + coli + 2 * vp);
        for (int ch = 0; ch < S / 64; ++ch) {
            float c0[8], c1[8];
            {
                float a0 = 0.f, a1 = 0.f;
#pragma unroll
                for (int i = 0; i < 8; ++i) { a0 += h2f_lo(rf[i]); a1 += h2f_hi(rf[i]); c0[i] = a0; c1[i] = a1; }
                *(LAS f32x2*)(SEG + seg * 128 + 2 * kp) = (f32x2){a0, a1};
            }
            __syncthreads();
            {
                float off0 = 0.f, off1 = 0.f, r0 = 0.f, r1 = 0.f, bl0 = 0.f, bl1 = 0.f;
#pragma unroll
                for (int s2 = 0; s2 < 8; ++s2) { const f32x2 t2 = *(const LAS f32x2*)(SEG + s2 * 128 + 2 * kp);
                    if (s2 < seg) { off0 += t2.x; off1 += t2.y; } if (s2 < 4) { r0 += t2.x; r1 += t2.y; } bl0 += t2.x; bl1 += t2.y; }
                const float eb0 = fexp(bl0 - r0), eb1 = fexp(bl1 - r1);
                v4u ke0, ke1; unsigned kw0[8], kw1[8];
#pragma unroll
                for (int i = 0; i < 8; ++i) {
                    const int t = 8 * seg + i;
                    const float e0 = fexp(off0 + c0[i] - r0), e1 = fexp(off1 + c1[i] - r1);
                    const float k0 = 1.f - fexp(h2f_lo(rf[i])), k1 = 1.f - fexp(h2f_hi(rf[i]));
                    const float i0 = k0 * fexp(r0 - off0 - c0[i]), i1 = k1 * fexp(r1 - off1 - c1[i]);
                    *(LAS unsigned*)(QD + t * HG_PK + 2 * kp) = pk2(bflo(rq[i]) * e0, bfhi(rq[i]) * e1);
                    *(LAS unsigned*)(KI + t * HG_PK + 2 * kp) = pk2(i0, i1);
                    kw0[i] = pk2(i0 * eb0, 0.f) & 0xffffu; kw1[i] = pk2(i1 * eb1, 0.f) & 0xffffu;
                }
                ke0.x = kw0[0] | (kw0[1] << 16); ke0.y = kw0[2] | (kw0[3] << 16); ke0.z = kw0[4] | (kw0[5] << 16); ke0.w = kw0[6] | (kw0[7] << 16);
                ke1.x = kw1[0] | (kw1[1] << 16); ke1.y = kw1[2] | (kw1[3] << 16); ke1.z = kw1[4] | (kw1[5] << 16); ke1.w = kw1[6] | (kw1[7] << 16);
                *(LAS v4u*)(KET + (2 * kp) * HG_PS + 8 * seg) = ke0; *(LAS v4u*)(KET + (2 * kp + 1) * HG_PS + 8 * seg) = ke1;
                v2u w0, w1;
                w0.x = (rv[0] & 0xffffu) | (rv[1] << 16); w0.y = (rv[2] & 0xffffu) | (rv[3] << 16);
                w1.x = (rv[0] >> 16) | (rv[1] & 0xffff0000u); w1.y = (rv[2] >> 16) | (rv[3] & 0xffff0000u);
                *(LAS v2u*)(VT + (2 * vp) * HG_PS + 4 * sg) = w0; *(LAS v2u*)(VT + (2 * vp + 1) * HG_PS + 4 * sg) = w1;
                float er[4], dec[4];
#pragma unroll
                for (int r = 0; r < 4; ++r) { const int k = 16 * wave + 4 * fq + r; float rr = 0.f, bb = 0.f;
#pragma unroll
                    for (int s2 = 0; s2 < 8; ++s2) { const float t2 = SEG[s2 * 128 + k]; if (s2 < 4) rr += t2; bb += t2; }
                    er[r] = fexp(rr); dec[r] = fexp(bb); }
#pragma unroll
                for (int vb = 0; vb < 4; ++vb) { v2u w; w.x = pk2(sacc[vb][0] * er[0], sacc[vb][1] * er[1]); w.y = pk2(sacc[vb][2] * er[2], sacc[vb][3] * er[3]);
                    *(LAS v2u*)(ST + (16 * vb + j) * HG_PK + 16 * wave + 4 * fq) = w;
                    sacc[vb][0] *= dec[0]; sacc[vb][1] *= dec[1]; sacc[vb][2] *= dec[2]; sacc[vb][3] *= dec[3]; }
            }
            __syncthreads();
            if (ch + 1 < S / 64) {
                const size_t r1 = row0 + (size_t)(ch + 1) * 64;
#pragma unroll
                for (int i = 0; i < 8; ++i) { rq[i] = *(gup)(HQ + (r1 + 8 * seg + i) * 1024 + colq + 2 * kp); rf[i] = *(gup)(HF + (r1 + 8 * seg + i) * 1024 + colq + 2 * kp); }
#pragma unroll
                for (int i = 0; i < 4; ++i) rv[i] = *(gup)(HI + (r1 + 4 * sg + i) * 1024 + coli + 2 * vp);
            }
            {
                const int tb = wave & 3;
#pragma unroll
                for (int q2 = 0; q2 < 2; ++q2) {
                    const int sb = 2 * (wave >> 2) + q2;
                    f32x4 a = (f32x4){0.f, 0.f, 0.f, 0.f};
                    if (sb <= tb) {
#pragma unroll
                        for (int ks = 0; ks < 4; ++ks) {
                            const bf16x8 af = *(const LAS bf16x8*)(KI + (16 * sb + j) * HG_PK + 32 * ks + 8 * fq), bfr_ = *(const LAS bf16x8*)(QD + (16 * tb + j) * HG_PK + 32 * ks + 8 * fq);
                            a = MFMA16H(af, bfr_, a);
                        }
                    }
                    float o[4];
#pragma unroll
                    for (int r = 0; r < 4; ++r) o[r] = (sb < tb || (sb == tb && 4 * fq + r <= j)) ? a[r] : 0.f;
                    v2u w; w.x = pk2(o[0], o[1]); w.y = pk2(o[2], o[3]);
                    *(LAS v2u*)(PP + (16 * tb + j) * HG_PS + 16 * sb + 4 * fq) = w;
                }
            }
            __syncthreads();
            {
                const int tb = wave & 3;
#pragma unroll
                for (int q2 = 0; q2 < 2; ++q2) {
                    const int vb = 2 * (wave >> 2) + q2;
                    f32x4 a = (f32x4){0.f, 0.f, 0.f, 0.f};
#pragma unroll
                    for (int sh = 0; sh < 2; ++sh) {
                        const bf16x8 af = *(const LAS bf16x8*)(VT + (16 * vb + j) * HG_PS + 32 * sh + 8 * fq), bfr_ = *(const LAS bf16x8*)(PP + (16 * tb + j) * HG_PS + 32 * sh + 8 * fq);
                        a = MFMA16H(af, bfr_, a);
                    }
#pragma unroll
                    for (int ks = 0; ks < 4; ++ks) {
                        const bf16x8 af = *(const LAS bf16x8*)(ST + (16 * vb + j) * HG_PK + 32 * ks + 8 * fq), bfr_ = *(const LAS bf16x8*)(QD + (16 * tb + j) * HG_PK + 32 * ks + 8 * fq);
                        a = MFMA16H(af, bfr_, a);
                    }
                    v2u w; w.x = pk2(a[0], a[1]); w.y = pk2(a[2], a[3]);
                    *(GAS v2u*)(ORAW + (row0 + (size_t)ch * 64 + 16 * tb + j) * 1024 + coli + 16 * vb + 4 * fq) = w;
                }
            }
#pragma unroll
            for (int sh = 0; sh < 2; ++sh) {
                const bf16x8 af = *(const LAS bf16x8*)(KET + (16 * wave + j) * HG_PS + 32 * sh + 8 * fq);
#pragma unroll
                for (int vb = 0; vb < 4; ++vb) { const bf16x8 bfr_ = *(const LAS bf16x8*)(VT + (16 * vb + j) * HG_PS + 32 * sh + 8 * fq); sacc[vb] = MFMA16H(af, bfr_, sacc[vb]); }
            }
            __syncthreads();
        }
    }
}

__device__ __forceinline__ void anorm_phase(const bf16* ORAW, const bf16* HG, const float* norm_g, bf16* AOUT, int G, int c, int wv) {
    const int tid = fresh_tid(wv), lane = tid & 63, gw = c * 8 + (tid >> 6), ngw = G * 8;
    const int e0 = (lane & 7) * 16, col = (lane >> 3) * 128 + e0;
    f32x4 ng[4];
#pragma unroll
    for (int i = 0; i < 4; ++i) ng[i] = *(const f32x4*)(norm_g + e0 + 4 * i);
    for (int row = gw; row < TG; row += ngw) {
        const v4u o0 = *(const v4u*)(ORAW + (size_t)row * 1024 + col), o1 = *(const v4u*)(ORAW + (size_t)row * 1024 + col + 8);
        const v4u g0 = *(const v4u*)(HG + (size_t)row * 1024 + col), g1 = *(const v4u*)(HG + (size_t)row * 1024 + col + 8);
        float o[16], gg[16];
        o[0] = bflo(o0.x); o[1] = bfhi(o0.x); o[2] = bflo(o0.y); o[3] = bfhi(o0.y); o[4] = bflo(o0.z); o[5] = bfhi(o0.z); o[6] = bflo(o0.w); o[7] = bfhi(o0.w);
        o[8] = bflo(o1.x); o[9] = bfhi(o1.x); o[10] = bflo(o1.y); o[11] = bfhi(o1.y); o[12] = bflo(o1.z); o[13] = bfhi(o1.z); o[14] = bflo(o1.w); o[15] = bfhi(o1.w);
        gg[0] = bflo(g0.x); gg[1] = bfhi(g0.x); gg[2] = bflo(g0.y); gg[3] = bfhi(g0.y); gg[4] = bflo(g0.z); gg[5] = bfhi(g0.z); gg[6] = bflo(g0.w); gg[7] = bfhi(g0.w);
        gg[8] = bflo(g1.x); gg[9] = bfhi(g1.x); gg[10] = bflo(g1.y); gg[11] = bfhi(g1.y); gg[12] = bflo(g1.z); gg[13] = bfhi(g1.z); gg[14] = bflo(g1.w); gg[15] = bfhi(g1.w);
        float ss = 0.f;
#pragma unroll
        for (int i = 0; i < 16; ++i) ss += o[i] * o[i];
        ss = sum8(ss);
        const float rs = frsq(ss * (1.0f / 128.0f) + RMS_EPS);
        float r[16];
#pragma unroll
        for (int i = 0; i < 16; ++i) r[i] = o[i] * rs * ng[i >> 2][i & 3] * siluf(gg[i]);
        v4u w0, w1;
        w0.x = pk2(r[0], r[1]); w0.y = pk2(r[2], r[3]); w0.z = pk2(r[4], r[5]); w0.w = pk2(r[6], r[7]);
        w1.x = pk2(r[8], r[9]); w1.y = pk2(r[10], r[11]); w1.z = pk2(r[12], r[13]); w1.w = pk2(r[14], r[15]);
        *(v4u*)(AOUT + (size_t)row * 1024 + col) = w0; *(v4u*)(AOUT + (size_t)row * 1024 + col + 8) = w1;
    }
}

__device__ __forceinline__ void ln_rows(const float* src, float* of, bf16* ob, const float* gam, const float* bet, int nrows, int G, int c, int wv, float oscale = 1.f) {
    const int tid = fresh_tid(wv), lane = tid & 63, gw = c * 8 + (tid >> 6), ngw = G * 8;
    f32x4 gv[4], bv[4];
#pragma unroll
    for (int j = 0; j < 4; ++j) { gv[j] = *(const f32x4*)(gam + 4 * lane + 256 * j); bv[j] = *(const f32x4*)(bet + 4 * lane + 256 * j); }
    for (int row = gw; row < nrows; row += ngw) {
        const f32x4* xr = (const f32x4*)(src + (size_t)row * 1024) + lane;
        f32x4 v[4]; float s = 0.f;
#pragma unroll
        for (int j = 0; j < 4; ++j) { v[j] = xr[64 * j]; s += (v[j].x + v[j].y) + (v[j].z + v[j].w); }
        const float mean = wave_sum(s) * (1.f / 1024.f); float s2 = 0.f;
#pragma unroll
        for (int j = 0; j < 4; ++j) { v[j] = v[j] - mean; s2 += (v[j].x * v[j].x + v[j].y * v[j].y) + (v[j].z * v[j].z + v[j].w * v[j].w); }
        const float rstd = frsq(wave_sum(s2) * (1.f / 1024.f) + LN_EPS);
#pragma unroll
        for (int j = 0; j < 4; ++j) {
            const f32x4 y = (v[j] * rstd * gv[j] + bv[j]) * oscale;
            if (of) *((f32x4*)(of + (size_t)row * 1024) + lane + 64 * j) = y;
            if (ob) { v2u w; w.x = pk2(y.x, y.y); w.y = pk2(y.z, y.w); *((v2u*)(ob + (size_t)row * 1024) + lane + 64 * j) = w; }
        }
    }
}

#define MFMA16(a, b, c) __builtin_amdgcn_mfma_f32_16x16x32_bf16((a), (b), (c), 0, 0, 0)

__device__ __forceinline__ void nsa_scores(const bf16* Kp, int kbase, int j, int fq, const bf16x8 (&qf)[2][2], f32x4 (&sc)[2][2][2]) {
    const bf16* kr = Kp + (size_t)(kbase + 8 * (j >> 2) + (j & 3)) * 64 + fq * 8;
#pragma unroll
    for (int kh = 0; kh < 2; ++kh)
#pragma unroll
        for (int kb = 0; kb < 2; ++kb) {
            const bf16x8 k0 = *(const bf16x8*)(kr + (size_t)(32 * kh + 4 * kb) * 64), k1 = *(const bf16x8*)(kr + (size_t)(32 * kh + 4 * kb) * 64 + 32);
#pragma unroll
            for (int rb = 0; rb < 2; ++rb) {
                f32x4 a = (f32x4){0.f, 0.f, 0.f, 0.f};
                a = MFMA16(k0, qf[rb][0], a); a = MFMA16(k1, qf[rb][1], a);
                sc[rb][kh][kb] = a;
            }
        }
}
__device__ __forceinline__ void nsa_pv(const bf16* Vt, int ldv, int kbase, int j, int fq, const bf16x8 (&pb)[2][2], f32x4 (&oacc)[2][4]) {
#pragma unroll
    for (int db = 0; db < 4; ++db)
#pragma unroll
        for (int kh = 0; kh < 2; ++kh) {
            const bf16x8 vf = *(const bf16x8*)(Vt + (size_t)(16 * db + j) * ldv + kbase + 32 * kh + 8 * fq);
#pragma unroll
            for (int rb = 0; rb < 2; ++rb) oacc[rb][db] = MFMA16(vf, pb[rb][kh], oacc[rb][db]);
        }
}
__device__ __forceinline__ bf16x8 pack_p(const f32x4& a, const f32x4& b) {
    v4u w; w.x = pk2(a[0], a[1]); w.y = pk2(a[2], a[3]); w.z = pk2(b[0], b[1]); w.w = pk2(b[2], b[3]); return __builtin_bit_cast(bf16x8, w);
}
__device__ __forceinline__ float fq_max(float v) { v = fmaxf(v, __shfl_xor(v, 16)); v = fmaxf(v, __shfl_xor(v, 32)); return v; }
__device__ __forceinline__ float fq_sum(float v) { v += __shfl_xor(v, 16); v += __shfl_xor(v, 32); return v; }

__device__ __forceinline__ void nsa_online(const bf16* Vt, int ldv, int kbase, int j, int fq, f32x4 (&sc)[2][2][2], const int (&lo)[2], const int (&hi)[2], float negb,
                                           float (&mrun)[2], float (&lrun)[2], f32x4 (&oacc)[2][4]) {
    bf16x8 pb[2][2];
#pragma unroll
    for (int rb = 0; rb < 2; ++rb) {
        float mx = negb;
#pragma unroll
        for (int kh = 0; kh < 2; ++kh)
#pragma unroll
            for (int kb = 0; kb < 2; ++kb)
#pragma unroll
                for (int r = 0; r < 4; ++r) { const int key = kbase + 32 * kh + 8 * fq + 4 * kb + r; const bool ok = key > lo[rb] && key <= hi[rb];
                    const float s = ok ? sc[rb][kh][kb][r] * SM_C : negb; sc[rb][kh][kb][r] = s; mx = fmaxf(mx, s); }
        mx = fq_max(mx);
        const float mnew = fmaxf(mrun[rb], mx), alpha = __builtin_amdgcn_exp2f(mrun[rb] - mnew);
        float ls = 0.f;
#pragma unroll
        for (int kh = 0; kh < 2; ++kh)
#pragma unroll
            for (int kb = 0; kb < 2; ++kb)
#pragma unroll
                for (int r = 0; r < 4; ++r) { const int key = kbase + 32 * kh + 8 * fq + 4 * kb + r; const bool ok = key > lo[rb] && key <= hi[rb];
                    const float p = ok ? __builtin_amdgcn_exp2f(sc[rb][kh][kb][r] - mnew) : 0.f; sc[rb][kh][kb][r] = p; ls += p; }
        ls = fq_sum(ls);
        lrun[rb] = lrun[rb] * alpha + ls; mrun[rb] = mnew;
#pragma unroll
        for (int db = 0; db < 4; ++db) oacc[rb][db] = oacc[rb][db] * alpha;
        pb[rb][0] = pack_p(sc[rb][0][0], sc[rb][0][1]); pb[rb][1] = pack_p(sc[rb][1][0], sc[rb][1][1]);
    }
    nsa_pv(Vt, ldv, kbase, j, fq, pb, oacc);
}


constexpr int NSA_PITCH = 72, NSA_TILE = 64 * NSA_PITCH * 2;
constexpr int NSA_KT = 0, NSA_VT = 2 * NSA_TILE, NSA_PS = 40960, NSA_SCS = 73728, NSA_PARK = 40960  , NSA_MSK = 110592, NSA_UM = 110848;
typedef const GAS v4u* gv4p;

__device__ __forceinline__ void nsa_scores_lds(const LAS bf16* KT, int j, int fq, const bf16x8 (&qf)[2][2], f32x4 (&sc)[2][2][2], const bool (&need)[2]) {
    const LAS bf16* kr = KT + j * NSA_PITCH + fq * 8;
#pragma unroll
    for (int kh = 0; kh < 2; ++kh)
#pragma unroll
        for (int kb = 0; kb < 2; ++kb) {
            const bf16x8 k0 = *(const LAS bf16x8*)(kr + (32 * kh + 16 * kb) * NSA_PITCH), k1 = *(const LAS bf16x8*)(kr + (32 * kh + 16 * kb) * NSA_PITCH + 32);
#pragma unroll
            for (int rb = 0; rb < 2; ++rb) {
                f32x4 a = (f32x4){0.f, 0.f, 0.f, 0.f};
                a = MFMA16(k0, qf[rb][0], a); a = MFMA16(k1, qf[rb][1], a);
                sc[rb][kh][kb] = a;
            }
            asm volatile("" ::: "memory");
        }
}
__device__ __forceinline__ void nsa_pv_lds(const LAS bf16* VT, int j, int fq, const bf16x8 (&pb)[2][2], f32x4 (&oacc)[2][4], const bool (&need)[2]) {
#pragma unroll
    for (int db = 0; db < 4; ++db)
#pragma unroll
        for (int kh = 0; kh < 2; ++kh) {
            const bf16x8 vf = *(const LAS bf16x8*)(VT + (16 * db + j) * NSA_PITCH + 32 * kh + 8 * fq);
#pragma unroll
            for (int rb = 0; rb < 2; ++rb) oacc[rb][db] = MFMA16(vf, pb[rb][kh], oacc[rb][db]);
            asm volatile("" ::: "memory");
        }
}
template <bool BOUNDS>
__device__ __forceinline__ void nsa_soft(f32x4 (&s)[2][2], int kbase, int fq, int lo, int hi, bool rowok, float negb, float& mrun, float& lrun, f32x4 (&oacc)[4], bf16x8 (&pb)[2]) {
    float mx = negb;
    const int lo2 = lo - kbase - 8 * fq, hi2 = hi - kbase - 8 * fq;
#pragma unroll
    for (int kh = 0; kh < 2; ++kh)
#pragma unroll
        for (int kb = 0; kb < 2; ++kb)
#pragma unroll
            for (int r = 0; r < 4; ++r) {
                if (BOUNDS) { const bool ok = (32 * kh + 4 * kb + r) > lo2 && (32 * kh + 4 * kb + r) <= hi2; s[kh][kb][r] = ok ? s[kh][kb][r] : negb; }
                mx = fmaxf(mx, s[kh][kb][r]);
            }
    if (!BOUNDS) mx = rowok ? mx : negb;
    if (BOUNDS || __ballot(mx > mrun + 8.0f) != 0ull) {
        mx = fq_max(mx);
        const float mnew = fmaxf(mrun, mx), alpha = __builtin_amdgcn_exp2f(mrun - mnew);
        lrun *= alpha; mrun = mnew;
#pragma unroll
        for (int db = 0; db < 4; ++db) oacc[db] = oacc[db] * alpha;
    }
    const float msub = (BOUNDS || rowok) ? mrun : 1e30f;
    float ls = 0.f;
#pragma unroll
    for (int kh = 0; kh < 2; ++kh)
#pragma unroll
        for (int kb = 0; kb < 2; ++kb)
#pragma unroll
            for (int r = 0; r < 4; ++r) {
                float p = __builtin_amdgcn_exp2f(s[kh][kb][r] - msub);
                if (BOUNDS) p = (s[kh][kb][r] > -1e29f) ? p : 0.f;
                s[kh][kb][r] = p; ls += p;
            }
    lrun += ls;
    pb[0] = pack_p(s[0][0], s[0][1]); pb[1] = pack_p(s[1][0], s[1][1]);
}

__device__ __forceinline__ void nsa_phase(LAS unsigned char* lds, int G, int c, int wv, size_t bout_off = WS_BOUT) {
    const int tid = fresh_tid(wv), lane = tid & 63, wave = __builtin_amdgcn_readfirstlane(tid >> 6), j = lane & 15, fq = lane >> 4, qq = j >> 2, g = j & 3;
    LAS float* ps = (LAS float*)(lds + NSA_PS + wave * 4096);
    LAS float* scs = (LAS float*)(lds + NSA_SCS + wave * 1024);
    LAS unsigned* msk = (LAS unsigned*)(lds + NSA_MSK + wave * 32);
    LAS unsigned* um = (LAS unsigned*)(lds + NSA_UM);
    LAS f32x4* park = (LAS f32x4*)(lds + NSA_PARK + wave * 8192) + lane;
    const int trow = tid >> 3, tch = (tid & 7) * 8;
    LAS bf16* const ldsb = (LAS bf16*)lds;
    const int st_off = trow * NSA_PITCH + tch;
    const int stk_off = ((trow & 32) + 16 * ((trow >> 2) & 1) + 4 * ((trow >> 3) & 3) + (trow & 3)) * NSA_PITCH + tch;
    float negb = NEG_BIG; asm volatile("" : "+v"(negb));
    constexpr int NUNITS = BG * 4 * 32;
#define NSA_UNIT(idx_, bh_, qb_) const int bh_ = (idx_) >> 5, qb_ = (((idx_) & 31) + 4 * ((idx_) >> 8)) & 31
    v4u rK0, rV0;
    rK0 = (v4u){0u, 0u, 0u, 0u}; rV0 = rK0;
    if (c < NUNITS) {
        NSA_UNIT(c, bh0, qb0); (void)qb0;
        unsigned char* const ws = KWS();
        const bf16* Kc = (const bf16*)(ws + WS_KCMP) + (size_t)bh0 * 128 * 64; const bf16* Vc = (const bf16*)(ws + WS_VCMPT) + (size_t)bh0 * 64 * 128;
        rK0 = *(gv4p)(Kc + trow * 64 + tch); rV0 = *(gv4p)(Vc + trow * 128 + tch);
    }
    for (int it = 0;; ++it) {
        const int idx = it * G + c; if (idx >= NUNITS) break;
        NSA_UNIT(idx, bh, qblk);
        const int b = bh >> 2, kvh = bh & 3, t0 = qblk * 64, cur = qblk;
        unsigned char* const ws = KWS();
        int tq[2]; tq[0] = t0 + 8 * wave + qq; tq[1] = tq[0] + 4;
        const bool two = (t0 + 63) >= 1055;
        if (two) {
            const bf16* Kc = (const bf16*)(ws + WS_KCMP) + (size_t)bh * 128 * 64; const bf16* Vc = (const bf16*)(ws + WS_VCMPT) + (size_t)bh * 64 * 128;
            const v4u rK1 = *(gv4p)(Kc + (64 + trow) * 64 + tch), rV1 = *(gv4p)(Vc + trow * 128 + 64 + tch);
            *(LAS v4u*)(ldsb + (NSA_KT + NSA_TILE) / 2 + stk_off) = rK1; *(LAS v4u*)(ldsb + (NSA_VT + NSA_TILE) / 2 + st_off) = rV1;
        }
        *(LAS v4u*)(ldsb + NSA_KT / 2 + stk_off) = rK0; *(LAS v4u*)(ldsb + NSA_VT / 2 + st_off) = rV0;
        __syncthreads();
        const int wlo = cur > 8 ? cur - 8 : 0;
        const bf16* Kw = (const bf16*)(ws + WS_KW) + (size_t)bh * S * 64; const bf16* Vw = (const bf16*)(ws + WS_VWT) + (size_t)bh * 64 * S;
        const bf16* Ks = (const bf16*)(ws + WS_KS) + (size_t)bh * S * 64; const bf16* Vs = (const bf16*)(ws + WS_VST) + (size_t)bh * 64 * S;
        rK0 = *(gv4p)(Kw + (size_t)(64 * wlo + trow) * 64 + tch); rV0 = *(gv4p)(Vw + (size_t)trow * S + 64 * wlo + tch);
        bf16x8 qf[2][2];
#pragma unroll
        for (int rb = 0; rb < 2; ++rb)
#pragma unroll
            for (int dh = 0; dh < 2; ++dh) qf[rb][dh] = __builtin_bit_cast(bf16x8, *(gv4p)((const bf16*)(ws + WS_NQ) + ((size_t)(b * 16 + kvh * 4 + g) * S + tq[rb]) * 64 + dh * 32 + fq * 8));
        f32x4 outv[2][4];
        const bool both[2] = {true, true};
        {
            int nmax[2];
#pragma unroll
            for (int rb = 0; rb < 2; ++rb) nmax[rb] = tq[rb] >= 31 ? ((tq[rb] - 31) >> 4) : -1;
            f32x4 s0[2][2][2], s1[2][2][2];
            nsa_scores_lds(ldsb + NSA_KT / 2, j, fq, qf, s0, both);
            if (two) nsa_scores_lds(ldsb + (NSA_KT + NSA_TILE) / 2, j, fq, qf, s1, both);
            else {
#pragma unroll
                for (int rb = 0; rb < 2; ++rb)
#pragma unroll
                    for (int kh = 0; kh < 2; ++kh)
#pragma unroll
                        for (int kb = 0; kb < 2; ++kb) s1[rb][kh][kb] = (f32x4){0.f, 0.f, 0.f, 0.f};
            }
            bf16x8 pb0[2][2], pb1[2][2];
#pragma unroll
            for (int rb = 0; rb < 2; ++rb) {
                float mx = negb;
                const int nm0 = nmax[rb] - 8 * fq, nm1 = nm0 - 64;
#pragma unroll
                for (int kh = 0; kh < 2; ++kh)
#pragma unroll
                    for (int kb = 0; kb < 2; ++kb)
#pragma unroll
                        for (int r = 0; r < 4; ++r) {
                            const float a = ((32 * kh + 4 * kb + r) <= nm0) ? s0[rb][kh][kb][r] : negb; s0[rb][kh][kb][r] = a; mx = fmaxf(mx, a);
                            const float bb = ((32 * kh + 4 * kb + r) <= nm1) ? s1[rb][kh][kb][r] : negb; s1[rb][kh][kb][r] = bb; mx = fmaxf(mx, bb);
                        }
                mx = fq_max(mx);
                float ls = 0.f;
#pragma unroll
                for (int kh = 0; kh < 2; ++kh)
#pragma unroll
                    for (int kb = 0; kb < 2; ++kb)
#pragma unroll
                        for (int r = 0; r < 4; ++r) {
                            const float a = ((32 * kh + 4 * kb + r) <= nm0) ? __builtin_amdgcn_exp2f(s0[rb][kh][kb][r] - mx) : 0.f; s0[rb][kh][kb][r] = a; ls += a;
                            const float bb = ((32 * kh + 4 * kb + r) <= nm1) ? __builtin_amdgcn_exp2f(s1[rb][kh][kb][r] - mx) : 0.f; s1[rb][kh][kb][r] = bb; ls += bb;
                        }
                ls = fq_sum(ls);
                const float inv = frcp(fmaxf(ls, 1e-30f));
#pragma unroll
                for (int kh = 0; kh < 2; ++kh) {
#pragma unroll
                    for (int kb = 0; kb < 2; ++kb) { s0[rb][kh][kb] = s0[rb][kh][kb] * inv; s1[rb][kh][kb] = s1[rb][kh][kb] * inv; }
                    pb0[rb][kh] = pack_p(s0[rb][kh][0], s0[rb][kh][1]); pb1[rb][kh] = pack_p(s1[rb][kh][0], s1[rb][kh][1]);
                    f32x4 a0, a1, b0, b1;
#pragma unroll
                    for (int r = 0; r < 4; ++r) { a0[r] = sum4(s0[rb][kh][0][r]); a1[r] = sum4(s0[rb][kh][1][r]); b0[r] = sum4(s1[rb][kh][0][r]); b1[r] = sum4(s1[rb][kh][1][r]); }
                    if (g == 0) {
                        LAS float* d = ps + (rb * 4 + qq) * 128 + 32 * kh + 8 * fq;
                        *(LAS f32x4*)d = a0; *(LAS f32x4*)(d + 4) = a1; *(LAS f32x4*)(d + 64) = b0; *(LAS f32x4*)(d + 68) = b1;
                    }
                }
            }
            f32x4 oc[2][4];
#pragma unroll
            for (int rb = 0; rb < 2; ++rb)
#pragma unroll
                for (int db = 0; db < 4; ++db) oc[rb][db] = (f32x4){0.f, 0.f, 0.f, 0.f};
            nsa_pv_lds(ldsb + NSA_VT / 2, j, fq, pb0, oc, both);
            if (two) nsa_pv_lds(ldsb + (NSA_VT + NSA_TILE) / 2, j, fq, pb1, oc, both);
#pragma unroll
            for (int rb = 0; rb < 2; ++rb) {
                const float gt = *(const GAS float*)((const float*)(ws + WS_GATES) + ((size_t)b * S + tq[rb]) * 48 + 0 * 16 + kvh * 4 + g);
#pragma unroll
                for (int db = 0; db < 4; ++db) outv[rb][db] = oc[rb][db] * gt;
            }
        }
        LDS_WAIT();
#pragma unroll 1
        for (int pass = 0; pass < 4; ++pass) {
            const int q8 = 2 * pass + (lane >> 5), k = lane & 31;
            const LAS float* pr = ps + q8 * 128;
            float imp = pr[4 * k] + pr[4 * k + 1] + pr[4 * k + 2] + 0.5f * pr[4 * k + 3];
            if (k > 0) imp += 0.5f * pr[4 * k - 1];
            const bool forced = (k == 0) || (k == cur) || (k == cur - 1);
            scs[q8 * 32 + k] = (k <= cur) ? imp + (forced ? 1000.0f : 0.0f) : -1.0f;
        }
        LDS_WAIT();
        unsigned wor = 0u;
#pragma unroll 1
        for (int pass = 0; pass < 4; ++pass) {
            const int q8 = 2 * pass + (lane >> 5), k = lane & 31;
            const LAS float* sr = scs + q8 * 32;
            const float my = sr[k];
            int rank = 0;
#pragma unroll
            for (int k2 = 0; k2 < 32; ++k2) { const float o = sr[k2]; rank += (o > my || (o == my && k2 < k)) ? 1 : 0; }
            const bool sel = (rank < 8) && (k <= cur);
            const unsigned long long bal = __ballot(sel);
            wor |= (unsigned)bal | (unsigned)(bal >> 32);
            if (lane == 0) { msk[2 * pass] = (unsigned)bal; msk[2 * pass + 1] = (unsigned)(bal >> 32); }
        }
        if (lane == 0) um[wave] = wor;
        LDS_WAIT();
        unsigned mym[2]; mym[0] = msk[qq]; mym[1] = msk[4 + qq];
        __syncthreads();
        *(LAS v4u*)(ldsb + NSA_KT / 2 + stk_off) = rK0; *(LAS v4u*)(ldsb + NSA_VT / 2 + st_off) = rV0;
        unsigned uni = 0u;
#pragma unroll
        for (int w = 0; w < 8; ++w) uni |= um[w];
        uni = __builtin_amdgcn_readfirstlane(uni) | 1u;
#pragma unroll
        for (int rb = 0; rb < 2; ++rb)
#pragma unroll
            for (int db = 0; db < 4; ++db) park[(rb * 4 + db) * 64] = outv[rb][db];
        __syncthreads();
        float mrun[2] = {negb, negb}, lrun[2] = {0.f, 0.f};
        f32x4 oa[2][4];
#pragma unroll
        for (int rb = 0; rb < 2; ++rb)
#pragma unroll
            for (int db = 0; db < 4; ++db) oa[rb][db] = (f32x4){0.f, 0.f, 0.f, 0.f};
        int stage = 1, k = wlo, p = 0;
        for (;;) {
            int nstage = stage, nk = 0; bool has_next = true;
            if (stage == 1) { if (k < cur) nk = k + 1; else { nstage = 2; nk = 0; } }
            else { const unsigned rem = (k >= 31) ? 0u : (uni & ~((2u << k) - 1u)); if (rem) nk = __builtin_ctz(rem); else has_next = false; }
            if (has_next) {
                const bf16* Kn = nstage == 1 ? Kw : Ks; const bf16* Vn = nstage == 1 ? Vw : Vs;
                rK0 = *(gv4p)(Kn + (size_t)(64 * nk + trow) * 64 + tch); rV0 = *(gv4p)(Vn + (size_t)trow * S + 64 * nk + tch);
            } else {
                const int nidx = idx + G;
                if (nidx < NUNITS) { NSA_UNIT(nidx, nbh, nqb); (void)nqb;
                    const bf16* Kc = (const bf16*)(ws + WS_KCMP) + (size_t)nbh * 128 * 64; const bf16* Vc = (const bf16*)(ws + WS_VCMPT) + (size_t)nbh * 64 * 128;
                    rK0 = *(gv4p)(Kc + trow * 64 + tch); rV0 = *(gv4p)(Vc + trow * 128 + tch); }
            }
            const LAS bf16* KT = ldsb + (NSA_KT + p * NSA_TILE) / 2; const LAS bf16* VT = ldsb + (NSA_VT + p * NSA_TILE) / 2;
            bool rowok[2], need[2];
#pragma unroll
            for (int rb = 0; rb < 2; ++rb) { rowok[rb] = stage == 1 ? true : (((mym[rb] >> k) & 1u) != 0u); need[rb] = __ballot(rowok[rb]) != 0ull; }
            if (need[0] || need[1]) {
                f32x4 sc[2][2][2];
                nsa_scores_lds(KT, j, fq, qf, sc, need);
                bf16x8 pb[2][2];
                const bool bounds = (k == cur) || (stage == 1 && k + 8 == cur);
                if (bounds) {
#pragma unroll
                    for (int rb = 0; rb < 2; ++rb) {
                        if (need[rb]) { const int lo = stage == 1 ? tq[rb] - 512 : -1, hi = rowok[rb] ? tq[rb] : -1;
                            nsa_soft<true>(sc[rb], 64 * k, fq, lo, hi, true, negb, mrun[rb], lrun[rb], oa[rb], pb[rb]); }
                        else { pb[rb][0] = (bf16x8){0, 0, 0, 0, 0, 0, 0, 0}; pb[rb][1] = pb[rb][0]; }
                    }
                } else {
#pragma unroll
                    for (int rb = 0; rb < 2; ++rb) {
                        if (need[rb]) nsa_soft<false>(sc[rb], 64 * k, fq, 0, 0, rowok[rb], negb, mrun[rb], lrun[rb], oa[rb], pb[rb]);
                        else { pb[rb][0] = (bf16x8){0, 0, 0, 0, 0, 0, 0, 0}; pb[rb][1] = pb[rb][0]; }
                    }
                }
                nsa_pv_lds(VT, j, fq, pb, oa, need);
            }
            if (stage == 1 && k == cur) {
#pragma unroll
                for (int rb = 0; rb < 2; ++rb) {
                    const float gt = *(const GAS float*)((const float*)(ws + WS_GATES) + ((size_t)b * S + tq[rb]) * 48 + 2 * 16 + kvh * 4 + g) * frcp(fmaxf(fq_sum(lrun[rb]), 1e-30f));
#pragma unroll
                    for (int db = 0; db < 4; ++db) { park[(rb * 4 + db) * 64] = park[(rb * 4 + db) * 64] + oa[rb][db] * gt; oa[rb][db] = (f32x4){0.f, 0.f, 0.f, 0.f}; }
                    mrun[rb] = negb; lrun[rb] = 0.f;
                }
            }
            if (has_next) { *(LAS v4u*)(ldsb + (NSA_KT + (p ^ 1) * NSA_TILE) / 2 + stk_off) = rK0; *(LAS v4u*)(ldsb + (NSA_VT + (p ^ 1) * NSA_TILE) / 2 + st_off) = rV0; }
            __syncthreads();
            if (!has_next) break;
            p ^= 1; stage = nstage; k = nk;
        }
#pragma unroll
        for (int rb = 0; rb < 2; ++rb) {
            const float gt = *(const GAS float*)((const float*)(ws + WS_GATES) + ((size_t)b * S + tq[rb]) * 48 + 1 * 16 + kvh * 4 + g) * frcp(fmaxf(fq_sum(lrun[rb]), 1e-30f));
            bf16* dst = (bf16*)(ws + bout_off) + ((size_t)b * S + tq[rb]) * 1024 + (kvh * 4 + g) * 64 + 4 * fq;
#pragma unroll
            for (int db = 0; db < 4; ++db) { f32x4 o = park[(rb * 4 + db) * 64] + oa[rb][db] * gt;
#if DBG_EXP == 3
                o = o * 0.f;
#endif
                v2u w; w.x = pk2(o[0], o[1]); w.y = pk2(o[2], o[3]); *(GAS v2u*)(dst + 16 * db) = w; }
        }
    }
#undef NSA_UNIT
}
#if DBG_CHK
__device__ __forceinline__ float bfr(float v) { return bflo(pk2(v, 0.f) & 0xffffu); }
__device__ __forceinline__ void dbg_flag(unsigned bit) { atomicOr((unsigned*)(KWS() + WS_CTL) + 8, bit); }
__device__ __forceinline__ bool dbg_bad(float got, float want) { return !(fabsf(got - want) <= 0.02f * fabsf(want) + 0.02f); }
__device__ __forceinline__ void dbg_check_proj(int G, int c, int wv) {
    const int tid = fresh_tid(wv), lane = tid & 63, gw = c * 8 + (tid >> 6), ngw = G * 8;
    unsigned char* ws = KWS(); const float* x = KIN(0); const float* win = KIN(2); const float* lb = (const float*)(ws + WS_VEC) + VEC_LB;
    for (int s = gw; s < 4096; s += ngw) {
        const int row = (s * 97) % TG, sel = s % 5, col = (s * 131) % 1024;
        const int src = sel < 4 ? sel * 1024 + col : 6704 + col;
        float acc = 0.f;
        for (int k = lane; k < 1024; k += 64) acc += bfr(x[(size_t)row * 1024 + k]) * bfr(win[(size_t)k * NSRC + src]);
        acc = wave_sum(acc);
        float got, want; unsigned bit;
        if (sel == 1) { const unsigned short h = ((const unsigned short*)(ws + WS_HF))[(size_t)row * 1024 + col]; got = (float)__builtin_bit_cast(_Float16, h); want = logf(lb[col] + (1.f - lb[col]) / (1.f + expf(-acc))); bit = 8u; }
        else if (sel == 4) { got = bflo(((const unsigned short*)(ws + WS_GA))[(size_t)row * 1024 + col]); want = 1.f / (1.f + expf(-acc)); bit = 8u; }
        else { const size_t base = sel == 0 ? WS_HQ : (sel == 2 ? WS_HI : WS_HG); got = bflo(((const unsigned short*)(ws + base))[(size_t)row * 1024 + col]); want = acc; bit = 4u; }
        if (lane == 0 && dbg_bad(got, want)) dbg_flag(bit);
    }
}
__device__ __forceinline__ void dbg_check_hgrn(int G, int c, int wv) {
    const int tid = fresh_tid(wv), lane = tid & 63, gw = c * 8 + (tid >> 6), ngw = G * 8;
    unsigned char* ws = KWS(); const bf16* HQ = (const bf16*)(ws + WS_HQ); const unsigned short* HF = (const unsigned short*)(ws + WS_HF); const bf16* HI = (const bf16*)(ws + WS_HI); const bf16* OR = (const bf16*)(ws + WS_ORAW);
    for (int s = gw; s < 256; s += ngw) {
        const int b = s & 15, h = (s >> 4) & 7, v = (s * 37 + 5) & 127;
        float s0 = 0.f, s1 = 0.f; int nbad = 0;
        for (int t = 0; t < S; ++t) {
            const size_t r = ((size_t)b * S + t) * 1024 + h * 128;
            const float f0 = expf((float)__builtin_bit_cast(_Float16, HF[r + lane])), f1 = expf((float)__builtin_bit_cast(_Float16, HF[r + lane + 64]));
            const float q0 = bflo(HQ[r + lane]), q1 = bflo(HQ[r + lane + 64]), iv = bflo(HI[r + v]);
            s0 = f0 * s0 + (1.f - f0) * iv; s1 = f1 * s1 + (1.f - f1) * iv;
            const float o = wave_sum(q0 * s0 + q1 * s1);
            if (!(fabsf(bflo(OR[r + v]) - o) <= 0.05f * fabsf(o) + 0.08f)) ++nbad;
        }
        if (lane == 0 && nbad > 0) dbg_flag(1u);
    }
}
__device__ __forceinline__ void dbg_check_anorm(int G, int c, int wv) {
    const int tid = fresh_tid(wv), lane = tid & 63, gw = c * 8 + (tid >> 6), ngw = G * 8;
    unsigned char* ws = KWS(); const bf16* OR = (const bf16*)(ws + WS_ORAW); const bf16* HG = (const bf16*)(ws + WS_HG); const bf16* AO = (const bf16*)(ws + WS_AOUT); const float* ng = KIN(4);
    for (int s = gw; s < 2048; s += ngw) {
        const int row = (s * 61) % TG, h = s & 7; const size_t r = (size_t)row * 1024 + h * 128;
        const float o0 = bflo(OR[r + lane]), o1 = bflo(OR[r + lane + 64]);
        const float ss = wave_sum(o0 * o0 + o1 * o1), rs = 1.f / sqrtf(ss / 128.f + RMS_EPS);
        const float g0 = bflo(HG[r + lane]), g1 = bflo(HG[r + lane + 64]);
        const float w0 = o0 * rs * ng[lane] * g0 / (1.f + expf(-g0)), w1 = o1 * rs * ng[lane + 64] * g1 / (1.f + expf(-g1));
        const bool bad = dbg_bad(bflo(AO[r + lane]), w0) || dbg_bad(bflo(AO[r + lane + 64]), w1);
        if (__ballot(bad) != 0ull && lane == 0) dbg_flag(2u);
    }
}
__device__ __forceinline__ void dbg_check_merge(int G, int c, int wv) {
    const int tid = fresh_tid(wv), lane = tid & 63, gw = c * 8 + (tid >> 6), ngw = G * 8;
    unsigned char* ws = KWS(); const bf16* AO = (const bf16*)(ws + WS_AOUT); const bf16* BO = (const bf16*)(ws + WS_BOUT); const bf16* GA = (const bf16*)(ws + WS_GA); const bf16* GB = (const bf16*)(ws + WS_GB); const bf16* MG = (const bf16*)(ws + WS_MERGED);
    const float* wa = KIN(15); const float* wb = KIN(16);
    for (int s = gw; s < 4096; s += ngw) {
        const int row = (s * 97) % TG, col = (s * 131) % 1024;
        float a = 0.f, b = 0.f;
        for (int k = lane; k < 1024; k += 64) { a += bflo(AO[(size_t)row * 1024 + k]) * bfr(wa[(size_t)k * 1024 + col]); b += bflo(BO[(size_t)row * 1024 + k]) * bfr(wb[(size_t)k * 1024 + col]); }
        a = wave_sum(a); b = wave_sum(b);
        const float want = bflo(GA[(size_t)row * 1024 + col]) * a + bflo(GB[(size_t)row * 1024 + col]) * b;
        if (lane == 0 && dbg_bad(bflo(MG[(size_t)row * 1024 + col]), want)) dbg_flag(DBG_CHK == 2 ? 1u : 0u);
    }
}
__device__ __forceinline__ void dbg_check_pre1(int G, int c, int wv) {
    const int tid = fresh_tid(wv), lane = tid & 63, gw = c * 8 + (tid >> 6), ngw = G * 8;
    unsigned char* ws = KWS(); const bf16* MG = (const bf16*)(ws + WS_MERGED); const float* P1 = (const float*)(ws + WS_PRE1); const float* wo = KIN(17); const float* x = KIN(0);
    for (int s = gw; s < 4096; s += ngw) {
        const int row = (s * 97) % TG, col = (s * 131) % 1024;
        float a = 0.f;
        for (int k = lane; k < 1024; k += 64) a += bflo(MG[(size_t)row * 1024 + k]) * bfr(wo[(size_t)k * 1024 + col]);
        a = wave_sum(a);
        const float want = DN_ALPHA * x[(size_t)row * 1024 + col] + a;
        if (lane == 0 && dbg_bad(P1[(size_t)row * 1024 + col], want)) dbg_flag(DBG_CHK == 2 ? 2u : 0u);
    }
}
#endif
#if DBG_CHK == 3
__device__ __forceinline__ int ipi64(int d) { return d < 32 ? 2 * d : 2 * (d - 32) + 1; }
__device__ __forceinline__ bool dbg_bad2(float got, float want, float rel, float ab) { return !(fabsf(got - want) <= rel * fabsf(want) + ab); }
__device__ __forceinline__ float wave_max(float v) {
#pragma unroll
    for (int o = 1; o < 64; o <<= 1) v = fmaxf(v, __shfl_xor(v, o));
    return v;
}
__device__ __forceinline__ void dbg_check_nsa(LAS unsigned char* lds, int G, int c, int wv) {
    const int tid = fresh_tid(wv), lane = tid & 63, gw = c * 8 + wv, ngw = G * 8;
    LAS float* Lq = (LAS float*)(lds + wv * 4096); LAS float* Lp = Lq + 256; LAS float* Ls = Lq + 768;
    unsigned char* ws = KWS();
    const bf16* NQ = (const bf16*)(ws + WS_NQ); const bf16* KS = (const bf16*)(ws + WS_KS); const bf16* VST = (const bf16*)(ws + WS_VST); const bf16* KW = (const bf16*)(ws + WS_KW); const bf16* VWT = (const bf16*)(ws + WS_VWT);
    const bf16* KCM = (const bf16*)(ws + WS_KCMP); const bf16* VCT = (const bf16*)(ws + WS_VCMPT); const float* GT = (const float*)(ws + WS_GATES); const bf16* BO = (const bf16*)(ws + WS_BOUT);
    for (int s = gw; s < 2048; s += ngw) {
        const int b = s & 15, kvh = (s >> 4) & 3;
        int t = (s * 613 + 17) & 2047; if (s < 64) t = s;
        const int bh = b * 4 + kvh, cur = t >> 6;
        _Pragma("unroll") for (int g = 0; g < 4; ++g) Lq[g * 64 + lane] = bflo(NQ[((size_t)(b * 16 + kvh * 4 + g) * S + t) * 64 + lane]);
        LDS_WAIT();
        float outv[4] = {0.f, 0.f, 0.f, 0.f};
        const int nmax = t >= 31 ? (t - 31) >> 4 : -1;
        float sc[4][2];
        _Pragma("unroll") for (int h2 = 0; h2 < 2; ++h2) { const int n = lane + 64 * h2;
            _Pragma("unroll") for (int g = 0; g < 4; ++g) { float a = 0.f; _Pragma("unroll 2") for (int d = 0; d < 64; ++d) a += Lq[g * 64 + d] * bflo(KCM[((size_t)bh * 128 + n) * 64 + d]); sc[g][h2] = n <= nmax ? a * 0.6931471805599453f : -1e30f; } }
        _Pragma("unroll") for (int g = 0; g < 4; ++g) {
            const float m = wave_max(fmaxf(sc[g][0], sc[g][1]));
            const float e0 = lane <= nmax ? expf(sc[g][0] - m) : 0.f, e1 = lane + 64 <= nmax ? expf(sc[g][1] - m) : 0.f;
            const float l = fmaxf(wave_sum(e0 + e1), 1e-30f);
            Lp[g * 128 + lane] = e0 / l; Lp[g * 128 + lane + 64] = e1 / l;
        }
        LDS_WAIT();
        _Pragma("unroll") for (int g = 0; g < 4; ++g) { float a = 0.f; _Pragma("unroll 2") for (int n = 0; n < 128; ++n) a += Lp[g * 128 + n] * bflo(VCT[((size_t)bh * 64 + lane) * 128 + n]);
            outv[g] = GT[((size_t)b * S + t) * 48 + 0 * 16 + kvh * 4 + g] * a; }
        if (lane < 32) { const int k = lane; float imp = 0.f;
            _Pragma("unroll") for (int g = 0; g < 4; ++g) { const LAS float* pr = Lp + g * 128; imp += pr[4 * k] + pr[4 * k + 1] + pr[4 * k + 2] + 0.5f * pr[4 * k + 3] + (k > 0 ? 0.5f * pr[4 * k - 1] : 0.f); }
            const bool forced = k == 0 || k == cur || k == cur - 1;
            Ls[k] = k <= cur ? imp + (forced ? 1000.f : 0.f) : -1.f; }
        LDS_WAIT();
        bool sel = false;
        if (lane < 32) { const float my = Ls[lane]; int rank = 0; _Pragma("unroll 2") for (int k2 = 0; k2 < 32; ++k2) { const float o = Ls[k2]; rank += (o > my || (o == my && k2 < lane)) ? 1 : 0; } sel = rank < 8 && lane <= cur; }
        const unsigned smask = (unsigned)__ballot(sel);
        LDS_WAIT();
        _Pragma("unroll 1") for (int br = 1; br < 3; ++br) {
            const bf16* Kp = (br == 1 ? KS : KW) + (size_t)bh * S * 64; const bf16* Vp = (br == 1 ? VST : VWT) + (size_t)bh * 64 * S;
            float m[4] = {-1e30f, -1e30f, -1e30f, -1e30f}, l[4] = {0.f, 0.f, 0.f, 0.f}, o[4] = {0.f, 0.f, 0.f, 0.f};
            const int k0 = br == 1 ? 0 : (cur > 8 ? cur - 8 : 0);
            _Pragma("unroll 1") for (int kb = k0; kb <= cur; ++kb) {
                if (br == 1 && !((smask >> kb) & 1u)) continue;
                const int key = 64 * kb + lane;
                const bool ok = key <= t && (br == 1 || key > t - 512);
                _Pragma("unroll") for (int g = 0; g < 4; ++g) {
                    float a = 0.f; _Pragma("unroll 2") for (int d = 0; d < 64; ++d) a += Lq[g * 64 + d] * bflo(Kp[(size_t)key * 64 + d]);
                    const float sv = ok ? a * 0.6931471805599453f : -1e30f;
                    const float mn = fmaxf(m[g], wave_max(sv)), al = expf(m[g] - mn), p = ok ? expf(sv - mn) : 0.f;
                    l[g] = l[g] * al + wave_sum(p); m[g] = mn; Lp[g * 128 + lane] = p; o[g] *= al;
                }
                LDS_WAIT();
                _Pragma("unroll") for (int g = 0; g < 4; ++g) { float a = 0.f; _Pragma("unroll 2") for (int j2 = 0; j2 < 64; ++j2) a += Lp[g * 128 + j2] * bflo(Vp[(size_t)lane * S + 64 * kb + j2]); o[g] += a; }
                LDS_WAIT();
            }
            _Pragma("unroll") for (int g = 0; g < 4; ++g) outv[g] += GT[((size_t)b * S + t) * 48 + br * 16 + kvh * 4 + g] * o[g] / fmaxf(l[g], 1e-30f);
        }
        bool bad = false;
        _Pragma("unroll") for (int g = 0; g < 4; ++g) bad |= dbg_bad2(bflo(BO[((size_t)b * S + t) * 1024 + (kvh * 4 + g) * 64 + lane]), outv[g], 0.04f, 0.006f);
        if (__ballot(bad) != 0ull && lane == 0) atomicAdd((unsigned*)(KWS() + WS_CTL) + 9, 1u);
        LDS_WAIT();
    }
}
__device__ __forceinline__ void dbg_check_cmp(LAS unsigned char* lds, int G, int c, int wv) {
    const int tid = fresh_tid(wv), lane = tid & 63, gw = c * 8 + wv, ngw = G * 8;
    LAS float* Lh = (LAS float*)(lds + 65536 + wv * 1024);
    unsigned char* ws = KWS();
    for (int s = gw; s < 256; s += ngw) {
        const int isv = s & 1, bh = (s >> 1) & 63, n = (s * 29 + 3) % 127;
        const bf16* X = (const bf16*)(ws + (isv ? WS_VC : WS_KC)) + (size_t)bh * S * 64;
        const float* pos = KIN(isv ? 10 : 5); const float* w1 = KIN(isv ? 11 : 6); const float* b1 = KIN(isv ? 12 : 7); const float* w2 = KIN(isv ? 13 : 8); const float* b2 = KIN(isv ? 14 : 9);
        float h[4] = {0.f, 0.f, 0.f, 0.f};
        for (int l = 0; l < 32; ++l) _Pragma("unroll 2") for (int d = 0; d < 64; ++d) {
            const float xv = bflo(X[(size_t)(16 * n + l) * 64 + (isv ? d : ipi64(d))]);
            _Pragma("unroll") for (int q = 0; q < 4; ++q) h[q] += xv * bfr(w1[(size_t)(l * 64 + d) * 256 + lane + 64 * q]) + pos[l * 64 + d] * w1[(size_t)(l * 64 + d) * 256 + lane + 64 * q];
        }
        _Pragma("unroll") for (int q = 0; q < 4; ++q) { const float z = h[q] + b1[lane + 64 * q]; Lh[lane + 64 * q] = bfr(z / (1.f + expf(-z))); }
        LDS_WAIT();
        float o = b2[lane];
        for (int j2 = 0; j2 < 256; ++j2) o += Lh[j2] * bfr(w2[j2 * 64 + lane]);
        const float got = isv ? bflo(((const bf16*)(ws + WS_VCMPT))[((size_t)bh * 64 + lane) * 128 + n]) : bflo(((const bf16*)(ws + WS_KCMP))[((size_t)bh * 128 + n) * 64 + ipi64(lane)]);
        if (__ballot(dbg_bad2(got, o, 0.03f, 0.02f)) != 0ull && lane == 0) dbg_flag(2u);
        LDS_WAIT();
    }
}
__device__ __forceinline__ void dbg_check_qkv(int G, int c, int wv) {
    const int tid = fresh_tid(wv), lane = tid & 63, gw = c * 8 + (tid >> 6), ngw = G * 8;
    unsigned char* ws = KWS(); const float* x = KIN(0); const float* win = KIN(2); const int* posi = (const int*)karg(1);
    for (int s = gw; s < 1024; s += ngw) {
        const int row = (s * 193 + 7) % TG, which = s % 7, b = row >> 11, t = row & 2047;
        const int head = which == 0 ? (s >> 3) & 15 : (s >> 3) & 3;
        const int src0 = which == 0 ? 4096 : 5120 + (which - 1) * 256;
        float a = 0.f;
        for (int k = 0; k < 1024; ++k) a += bfr(x[(size_t)row * 1024 + k]) * bfr(win[(size_t)k * NSRC + src0 + head * 64 + lane]);
        float want = a; bool isk = which == 0 || which == 1 || which == 3 || which == 5;
        if (isk) { const float partner = __shfl_xor(a, 32); const int i = lane & 31; const float ang = (float)posi[row] * powf(10000.f, -(float)i / 32.f);
            const float cs = cosf(ang), sn = sinf(ang); want = lane < 32 ? a * cs - partner * sn : a * cs + partner * sn; }
        float got; unsigned bit = isk ? 4u : 8u;
        if (which == 0) { got = bflo(((const bf16*)(ws + WS_NQ))[((size_t)(b * 16 + head) * S + t) * 64 + ipi64(lane)]); want *= SM_C; }
        else if (which == 4 || which == 6) got = bflo(((const bf16*)(ws + (which == 4 ? WS_VST : WS_VWT)))[((size_t)(b * 4 + head) * 64 + lane) * S + t]);
        else { const size_t base = which == 1 ? WS_KC : (which == 2 ? WS_VC : (which == 3 ? WS_KS : WS_KW)); got = bflo(((const bf16*)(ws + base))[((size_t)(b * 4 + head) * S + t) * 64 + (isk ? ipi64(lane) : lane)]); }
        if (__ballot(dbg_bad2(got, want, 0.02f, 0.02f)) != 0ull && lane == 0) dbg_flag(bit);
    }
}
#endif
#ifndef PH_P0
#define PH_P0 1
#endif
#ifndef PH_P1
#define PH_P1 1
#endif
#ifndef PH_CMP
#define PH_CMP 1
#endif
#ifndef PH_HG
#define PH_HG 1
#endif
#ifndef PH_AN
#define PH_AN 1
#endif
#ifndef PH_NSA
#define PH_NSA 1
#endif
#ifndef PH_P4
#define PH_P4 1
#endif
#ifndef PH_P5
#define PH_P5 1
#endif
#ifndef PH_LN
#define PH_LN 1
#endif
#ifndef PH_P7
#define PH_P7 1
#endif
#ifndef PH_P8
#define PH_P8 1
#endif
struct Args { const void* in[25]; float* out; unsigned char* ws; };

__global__ void __launch_bounds__(512, 2) nsa_hgrn_fwd(Args args) {
    extern __shared__ __attribute__((aligned(16))) unsigned char lds_raw[];
    LAS unsigned char* lds = (LAS unsigned char*)lds_raw;
    const int G = gridDim.x, c = blockIdx.x, wv = __builtin_amdgcn_readfirstlane(threadIdx.x >> 6);
    unsigned char* ws = KWS();
    for (int u = threadIdx.x; u < (LDS_BYTES - LDSCTL_OFF) / 4; u += 512) ((LAS unsigned*)(lds + LDSCTL_OFF))[u] = 0u;
    __syncthreads();
    XcdBarrier bar = xcd_barrier_post((unsigned*)(ws + WS_CTL) + CW_BAR, (volatile LAS unsigned*)(lds + MISC_OFF) + 8);


#if PH_P0
    {
        const int tid = fresh_tid(wv), lane = tid & 63, wave = __builtin_amdgcn_readfirstlane(tid >> 6), gw = c * 8 + wave, ngw = G * 8, gt = c * 512 + tid, ngt = G * 512;
        LAS float* scr = (LAS float*)(lds + wave * 16384);
        constexpr int I_WIN = 16 * (NPROJ / 32), I_SQ = 16 * 32, I_GU = 16 * (NGU / 32), I_D = (DFF / 64) * 32, I_C1 = 32 * 16, I_C2 = 4 * 16;
        constexpr int NITEMS = I_WIN + 3 * I_SQ + I_GU + I_D + I_C1 + I_C2;
        const SrcWin fwin{KIN(2)};
        const SrcPlain fa{KIN(15), 1024}, fb{KIN(16), 1024}, fo{KIN(17), 1024}, fd{KIN(22), 1024};
        const SrcGU fgu{KIN(20), KIN(21)};
        const SrcCW1 fc1{KIN(6), KIN(11)};
        const SrcCW2 fc2{KIN(8), KIN(13)};
        for (int it = gw; it < NITEMS; it += ngw) {
            int r = it;
            if (r < I_WIN) { tr_item(fwin, (bf16*)(KWS() + WS_WIN), 1024, NPROJ, r, scr, lane); continue; } r -= I_WIN;
            if (r < I_SQ) { tr_item(fa, (bf16*)(KWS() + WS_WA), 1024, 1024, r, scr, lane); continue; } r -= I_SQ;
            if (r < I_SQ) { tr_item(fb, (bf16*)(KWS() + WS_WB), 1024, 1024, r, scr, lane); continue; } r -= I_SQ;
            if (r < I_SQ) { tr_item(fo, (bf16*)(KWS() + WS_WO), 1024, 1024, r, scr, lane); continue; } r -= I_SQ;
            if (r < I_GU) { tr_item(fgu, (bf16*)(KWS() + WS_WGU), 1024, NGU, r, scr, lane); continue; } r -= I_GU;
            if (r < I_D) { tr_item(fd, (bf16*)(KWS() + WS_WD), DFF, 1024, r, scr, lane); continue; } r -= I_D;
            if (r < I_C1) { tr_item(fc1, (bf16*)(KWS() + WS_CW1), 2048, 512, r, scr, lane); continue; } r -= I_C1;
            tr_item(fc2, (bf16*)(KWS() + WS_CW2), 256, 512, r, scr, lane);
        }
        const float* lbl = KIN(3);
        for (int i = gt; i < 1024; i += ngt) ((float*)(KWS() + WS_VEC))[VEC_LB + i] = sigm(lbl[i] - lbl[1024 + i]);
        for (int o = gw; o < 512; o += ngw) {
            const bool isv = o >= 256; const int jj = o & 255;
            const float* pos = KIN(isv ? 10 : 5); const float* w1 = KIN(isv ? 11 : 6); const float* b1 = KIN(isv ? 12 : 7);
            float s = 0.f;
            for (int kk = lane; kk < 2048; kk += 64) s += pos[kk] * w1[(size_t)kk * 256 + jj];
            s = wave_sum(s);
            if (lane == 0) ((float*)(KWS() + WS_VEC))[VEC_CB1 + o] = s + b1[jj];
        }
        for (int i = gt; i < 512; i += ngt) {
            float v = 0.f;
            if (i < 64) v = (KIN(9))[pi64(i)]; else if (i >= 256 && i < 320) v = (KIN(14))[i - 256];
            ((float*)(KWS() + WS_VEC))[VEC_CB2 + i] = v;
        }
        for (int e = gt; e < BATCH * S * 32; e += ngt) {
            const float ang = (float)((const int*)karg(1))[e >> 5] * ROPE_INVF[e & 31];
            float cs, sn; sincos_acc(ang, cs, sn);
            ((f32x2*)(KWS() + WS_ROPE))[e] = (f32x2){cs, sn};
        }
    }

#endif
    for (int grp = 0; grp < NGRP; ++grp) {
        {
            const int gt = fresh_s(c) * 512 + fresh_tid(wv), ngt = fresh_s(G) * 512;
            bf16* XB = (bf16*)(KWS() + WS_XB); const float* xg = KIN(0) + (size_t)grp * TG * 1024;
            for (int i = gt; i < TG * 1024 / 8; i += ngt) {
                const f32x4 a = *(const f32x4*)(xg + (size_t)i * 8), b2 = *(const f32x4*)(xg + (size_t)i * 8 + 4);
                v4u w; w.x = pk2(a[0], a[1]); w.y = pk2(a[2], a[3]); w.z = pk2(b2[0], b2[1]); w.w = pk2(b2[2], b2[3]);
                *(v4u*)(XB + (size_t)i * 8) = w;
            }
        }
        xcd_barrier(bar);
#if PH_P1
        {
            pg8::Gemm g{(const bf16*)(KWS() + WS_XB), (const bf16*)(KWS() + WS_WIN), TG, NPROJ, 1024, 1024};
            pg8::StaticOrder So; So.init(TG, NPROJ, fresh_s(G), fresh_s(c));
            EpiProj E{grp};
            pg8::gemm_phase<EpiProj, pg8::StaticOrder, true, true>(lds, g, So, E, wv);
        }
#endif
        xcd_barrier(bar);
#if DBG_CHK == 1
        if (grp == 0) dbg_check_proj(fresh_s(G), fresh_s(c), wv);
#endif
#if DBG_CHK == 3
        if (grp == 0 && (DBG_SUB & 4)) dbg_check_qkv(fresh_s(G), fresh_s(c), wv);
#endif
#if PH_CMP
        if (fresh_s(c) < 64) {
            const int cc = fresh_s(c);
            {
                pg8::Gemm g{(const bf16*)(KWS() + WS_KC), (const bf16*)(KWS() + WS_CW1), 16384, 512, 2048, 1024};
                OneUnit So{cc, cc >> 5, true};
                EpiCmp1 E{(bf16*)(KWS() + WS_HC), (float*)(KWS() + WS_VEC) + VEC_CB1};
                pg8::gemm_phase<EpiCmp1, OneUnit, false, true>(lds, g, So, E, wv);
            }
            VM_WAIT(); __syncthreads();
            {
                pg8::Gemm g{(const bf16*)(KWS() + WS_HC), (const bf16*)(KWS() + WS_CW2), 16384, 512, 256, 256};
                OneUnit So{cc, cc >> 5, true};
                EpiCmp2 E{(bf16*)(KWS() + WS_KCMP), (bf16*)(KWS() + WS_VCMPT), (float*)(KWS() + WS_VEC) + VEC_CB2};
                pg8::gemm_phase<EpiCmp2, OneUnit, false, true>(lds, g, So, E, wv);
            }
            __syncthreads();
        }
#endif
#if PH_HG
        hgrn_phase(lds, (const bf16*)(KWS() + WS_HQ), (const bf16*)(KWS() + WS_HF), (const bf16*)(KWS() + WS_HI), (bf16*)(KWS() + WS_ORAW), fresh_s(G), fresh_s(c), wv);
#if DUP_HG
        __syncthreads(); hgrn_phase(lds, (const bf16*)(KWS() + WS_HQ), (const bf16*)(KWS() + WS_HF), (const bf16*)(KWS() + WS_HI), (bf16*)(KWS() + WS_ORAW), fresh_s(G), fresh_s(c), wv);
#endif
#endif
        xcd_barrier(bar);
#if DBG_CHK == 1
        if (grp == 0) dbg_check_hgrn(fresh_s(G), fresh_s(c), wv);
#endif
#if PH_AN
        anorm_phase((const bf16*)(KWS() + WS_ORAW), (const bf16*)(KWS() + WS_HG), KIN(4), (bf16*)(KWS() + WS_AOUT), fresh_s(G), fresh_s(c), wv);
#endif
#if PH_NSA
        {
            nsa_phase(lds, fresh_s(G), fresh_s(c), wv);
#if DUP_NSA
            __syncthreads(); nsa_phase(lds, fresh_s(G), fresh_s(c), wv);
#endif
        }
#endif
        xcd_barrier(bar);
#if DBG_CHK == 1
        if (grp == 0) dbg_check_anorm(fresh_s(G), fresh_s(c), wv);
#endif
#if DBG_CHK == 4
        {
            const int cc2 = fresh_s(c), GG2 = fresh_s(G);
            nsa_phase(lds, GG2, cc2, wv, (size_t)880 * MiB);
            xcd_barrier(bar);
            const int gt2 = cc2 * 512 + fresh_tid(wv), ngt2 = GG2 * 512; unsigned nb = 0;
            const v4u* p1 = (const v4u*)(KWS() + WS_BOUT); const v4u* p2 = (const v4u*)(KWS() + (size_t)880 * MiB);
            for (int i = gt2; i < TG * 1024 / 8; i += ngt2) { const v4u a = p1[i], b2 = p2[i]; nb += (a.x != b2.x || a.y != b2.y || a.z != b2.z || a.w != b2.w) ? 1u : 0u; }
            if (nb) atomicAdd((unsigned*)(KWS() + WS_CTL) + 9, nb);
        }
#endif
#if DBG_CHK == 3
        if (grp == 0) { if (DBG_SUB & 1) dbg_check_nsa(lds, fresh_s(G), fresh_s(c), wv); if (DBG_SUB & 2) dbg_check_cmp(lds, fresh_s(G), fresh_s(c), wv); }
        __syncthreads();
#endif
#if DBG_DELAY
        if ((fresh_s(c) % 3) == 0) { const unsigned long long t0 = __builtin_amdgcn_s_memrealtime(); while (__builtin_amdgcn_s_memrealtime() - t0 < (unsigned long long)DBG_DELAY * 100ull) __builtin_amdgcn_s_sleep(8); }
#endif
#if PH_P4
        {
            pg8::StaticOrder So; So.init(TG, 1024, fresh_s(G), fresh_s(c));
            {
                pg8::Gemm g{(const bf16*)(KWS() + WS_AOUT), (const bf16*)(KWS() + WS_WA), TG, 1024, 1024, 1024};
                EpiMerge<false> E{};
                pg8::gemm_phase<EpiMerge<false>, pg8::StaticOrder, true, true>(lds, g, So, E, wv);
            }
            VM_WAIT(); __syncthreads();
            {
                pg8::Gemm g{(const bf16*)(KWS() + WS_BOUT), (const bf16*)(KWS() + WS_WB), TG, 1024, 1024, 1024};
                EpiMerge<true> E{};
                pg8::gemm_phase<EpiMerge<true>, pg8::StaticOrder, true, true>(lds, g, So, E, wv);
            }
        }
#endif
        xcd_barrier(bar);
#if DBG_CHK == 2
        if (grp == 0) dbg_check_merge(fresh_s(G), fresh_s(c), wv);
#endif
#if PH_P5
        {
            pg8::Gemm g{(const bf16*)(KWS() + WS_MERGED), (const bf16*)(KWS() + WS_WO), TG, 1024, 1024, 1024};
            pg8::StaticOrder So; So.init(TG, 1024, fresh_s(G), fresh_s(c));
            EpiResid E{KIN(0) + (size_t)grp * TG * 1024, (float*)(KWS() + WS_PRE1), DBG_EXP == 5 ? 0.f : 1.f};
            pg8::gemm_phase<EpiResid, pg8::StaticOrder, true, true>(lds, g, So, E, wv);
        }
#endif
        xcd_barrier(bar);
#if DBG_CHK == 2
        if (grp == 0) dbg_check_pre1(fresh_s(G), fresh_s(c), wv);
#endif
#if PH_LN
        ln_rows((const float*)(KWS() + WS_PRE1), (float*)(KWS() + WS_PRE1), (bf16*)(KWS() + WS_H1B), KIN(18), KIN(19), TG, fresh_s(G), fresh_s(c), wv);
#endif
        xcd_barrier(bar);
#if PH_P7
        {
            pg8::Gemm g{(const bf16*)(KWS() + WS_H1B), (const bf16*)(KWS() + WS_WGU), TG, NGU, 1024, 1024};
            pg8::StaticOrder So; So.init(TG, NGU, fresh_s(G), fresh_s(c));
            EpiGU E{(bf16*)(KWS() + WS_HID)};
            pg8::gemm_phase<EpiGU, pg8::StaticOrder, true, true>(lds, g, So, E, wv);
        }
#endif
        xcd_barrier(bar);
#if PH_P8
        {
            pg8::Gemm g{(const bf16*)(KWS() + WS_HID), (const bf16*)(KWS() + WS_WD), TG, 1024, DFF, DFF};
            pg8::StaticOrder So; So.init(TG, 1024, fresh_s(G), fresh_s(c));
            EpiResid E{(const float*)(KWS() + WS_PRE1), KOUT() + (size_t)grp * TG * 1024, DBG_EXP == 6 ? 0.f : 1.f};
            pg8::gemm_phase<EpiResid, pg8::StaticOrder, true, true>(lds, g, So, E, wv);
        }
#endif
        xcd_barrier(bar);
        { float* outg = KOUT() + (size_t)grp * TG * 1024;
        ln_rows(outg, outg, nullptr, KIN(23), KIN(24), TG, fresh_s(G), fresh_s(c), wv, DBG_CHK ? 1.f + (float)__hip_atomic_load((unsigned*)(KWS() + WS_CTL) + 8, __ATOMIC_RELAXED, __HIP_MEMORY_SCOPE_AGENT) + (float)__hip_atomic_load((unsigned*)(KWS() + WS_CTL) + 9, __ATOMIC_RELAXED, __HIP_MEMORY_SCOPE_AGENT) * (1.f / DBG_NDIV) : 1.f); }
    }
}

extern "C" void kernel_launch(void* const* d_in, const int* in_sizes, int n_in, void* d_out, int out_size, void* d_ws, size_t ws_size, hipStream_t stream) {
    static int grid = 0;
    if (grid == 0) {
        if (n_in != 25 || in_sizes[0] != BATCH * S * D || out_size != BATCH * S * D || ws_size < WS_END) {
            fprintf(stderr, "kernel_launch: unexpected problem (n_in %d, in0 %d, out %d, ws %zu; need ws >= %zu); nothing launched\n", n_in, n_in > 0 ? in_sizes[0] : -1, out_size, ws_size, (size_t)WS_END);
            grid = -1; return; }
        int dev = 0, cus = 0, per_cu = 0;
        if (hipGetDevice(&dev) != hipSuccess || hipDeviceGetAttribute(&cus, hipDeviceAttributeMultiprocessorCount, dev) != hipSuccess) { grid = -1; return; }
        if (hipFuncSetAttribute((const void*)nsa_hgrn_fwd, hipFuncAttributeMaxDynamicSharedMemorySize, LDS_BYTES) != hipSuccess) { fprintf(stderr, "kernel_launch: hipFuncSetAttribute failed\n"); grid = -1; return; }
        if (hipOccupancyMaxActiveBlocksPerMultiprocessor(&per_cu, (const void*)nsa_hgrn_fwd, 512, LDS_BYTES) != hipSuccess || per_cu < 1)
            fprintf(stderr, "kernel_launch: note: occupancy query reports %d workgroups per CU\n", per_cu);
        (void)hipGetLastError();
        grid = cus;
    }
    if (grid < 0) return;
    if (hipMemsetAsync((char*)d_ws + WS_CTL, 0, CTL_ZERO_BYTES, stream) != hipSuccess) return;
    Args a{};
    for (int i = 0; i < 25; ++i) a.in[i] = d_in[i];
    a.out = (float*)d_out; a.ws = (unsigned char*)d_ws;
    hipLaunchKernelGGL(nsa_hgrn_fwd, dim3(grid), dim3(512), LDS_BYTES, stream, a);
}
```
